# Optimizing an MI355X kernel written in HIP

```python
import math
import jax, jax.numpy as jnp
from jax import lax
import numpy as np

D_MODEL = 1024
BATCH = 8
SEQ = 2048
DEPTH = 2
DEC_BATCH = 128
DEC_SEQ = 8
PAST_LEN = 16384
PAGE_SIZE = 128

N_MIXERS = 2
N_POOL_LAYERS = (DEPTH + 1) // 2
N_SSM_LAYERS = DEPTH // 2
POOL_WINDOWS = (2, 4, 8, 16)
N_POOL_GROUPS = len(POOL_WINDOWS)
POOL_GROUP_DIM = D_MODEL // N_POOL_GROUPS
POOL_BUF = max(POOL_WINDOWS) - 1
SSM_GROUP_DIM = 16
SSM_GROUPS = D_MODEL // SSM_GROUP_DIM
SSM_STATE = 64
SCAN_BLOCK = 128
D_FF = -(-(8 * D_MODEL) // (3 * 256)) * 256
PLE_DIM = 256
EPS = 1e-6

kernel_name = "pool_s5_hybrid_decode_step"


def rmsnorm(x, g):
    xf = x.astype(jnp.float32)
    y = xf * lax.rsqrt(jnp.mean(xf * xf, axis=-1, keepdims=True) + EPS) * g.astype(jnp.float32)
    return y.astype(x.dtype)


def pool_mixer(h, prev, start, w_grp, scale):
    bt, t_len, _ = h.shape
    rows = jnp.concatenate([prev.astype(jnp.float32), h.astype(jnp.float32)], axis=1)
    cs = jnp.concatenate([jnp.zeros((bt, 1, D_MODEL), jnp.float32), jnp.cumsum(rows, axis=1)], axis=1)
    end = cs[:, POOL_BUF + 1:]
    pos = start + jnp.arange(t_len)
    outs = []
    for gi, w in enumerate(POOL_WINDOWS):
        c0, c1 = gi * POOL_GROUP_DIM, (gi + 1) * POOL_GROUP_DIM
        beg = cs[:, POOL_BUF + 1 - w: POOL_BUF + 1 - w + t_len, c0:c1]
        cnt = jnp.minimum(w, pos + 1).astype(jnp.float32)[None, :, None]
        diff = (end[..., c0:c1] - beg) / cnt - rows[:, POOL_BUF:, c0:c1]
        outs.append(jnp.einsum('btc,cd->btd', diff, w_grp[gi].astype(jnp.float32)))
    out = jnp.concatenate(outs, axis=-1) * scale.astype(jnp.float32)
    return out.astype(h.dtype), rows[:, -POOL_BUF:].astype(prev.dtype)


def _complex_affine_combine(e1, e2):
    a1r, a1i, b1r, b1i = e1
    a2r, a2i, b2r, b2i = e2
    return (a2r * a1r - a2i * a1i,
            a2r * a1i + a2i * a1r,
            a2r * b1r - a2i * b1i + b2r,
            a2r * b1i + a2i * b1r + b2i)


def ssm_mixer(h, h0_re, h0_im, lam_re, lam_im, log_dt, b_re, b_im, c_re, c_im, d, w_glu):
    bt, t_len, _ = h.shape
    f32 = jnp.float32
    lam_re = lam_re.astype(f32); lam_im = lam_im.astype(f32)
    dt = jnp.exp(log_dt.astype(f32))[:, None]
    mag = jnp.exp(lam_re * dt)
    lb_re = mag * jnp.cos(lam_im * dt)
    lb_im = mag * jnp.sin(lam_im * dt)
    den = lam_re * lam_re + lam_im * lam_im
    f_re = ((lb_re - 1.0) * lam_re + lb_im * lam_im) / den
    f_im = (lb_im * lam_re - (lb_re - 1.0) * lam_im) / den
    b_re = b_re.astype(f32); b_im = b_im.astype(f32)
    bb_re = f_re[..., None] * b_re - f_im[..., None] * b_im
    bb_im = f_re[..., None] * b_im + f_im[..., None] * b_re
    c_re = c_re.astype(f32); c_im = c_im.astype(f32)

    u = h.astype(f32)
    blk = SCAN_BLOCK if t_len % SCAN_BLOCK == 0 else t_len
    nb = t_len // blk
    ub = u.reshape(bt, nb, blk, SSM_GROUPS, SSM_GROUP_DIM).transpose(1, 0, 2, 3, 4)

    def step(carry, u_blk):
        hr, hi = carry
        br = jnp.einsum('blgh,gph->blgp', u_blk, bb_re)
        bi = jnp.einsum('blgh,gph->blgp', u_blk, bb_im)
        br = br.at[:, 0].add(lb_re * hr - lb_im * hi)
        bi = bi.at[:, 0].add(lb_re * hi + lb_im * hr)
        ar = jnp.broadcast_to(lb_re, br.shape)
        ai = jnp.broadcast_to(lb_im, br.shape)
        _, _, sr, si = lax.associative_scan(_complex_affine_combine, (ar, ai, br, bi), axis=1)
        y = jnp.einsum('blgp,ghp->blgh', sr, c_re) - jnp.einsum('blgp,ghp->blgh', si, c_im)
        return (sr[:, -1], si[:, -1]), y

    (hr, hi), ys = lax.scan(step, (h0_re.astype(f32), h0_im.astype(f32)), ub)
    y = ys.transpose(1, 0, 2, 3, 4).reshape(bt, t_len, D_MODEL) + d.astype(f32) * u
    z = jax.nn.gelu(y)
    a, g = jnp.split(jnp.einsum('btd,de->bte', z, w_glu.astype(f32)), 2, axis=-1)
    out = a * jax.nn.sigmoid(g)
    return out.astype(h.dtype), hr.astype(h0_re.dtype), hi.astype(h0_im.dtype)


def swiglu(h, w_gate, w_up, w_down):
    return (jax.nn.silu(h @ w_gate) * (h @ w_up)) @ w_down


def per_layer_embed(x, p_i, g, w_in, w_gate):
    gate = jax.nn.sigmoid(rmsnorm(x, g) @ w_gate)
    return (p_i @ w_in) * gate


def run_trunk(x, p, start, pool_state, ssm_re, ssm_im, prm):
    pool_new, re_new, im_new = [], [], []
    for i in range(DEPTH):
        j = i // N_MIXERS
        h = rmsnorm(x, prm['g_mix'][i])
        if i % N_MIXERS == 0:
            out, st = pool_mixer(h, pool_state[j], start, prm['pool_w'][j], prm['pool_scale'][j])
            pool_new.append(st)
        else:
            out, sr, si = ssm_mixer(h, ssm_re[j], ssm_im[j], prm['ssm_lambda_re'][j], prm['ssm_lambda_im'][j],
                                    prm['ssm_log_dt'][j], prm['ssm_b_re'][j], prm['ssm_b_im'][j],
                                    prm['ssm_c_re'][j], prm['ssm_c_im'][j], prm['ssm_d'][j], prm['ssm_w_glu'][j])
            re_new.append(sr)
            im_new.append(si)
        x = x + out
        x = x + swiglu(rmsnorm(x, prm['g_ffn'][i]), prm['ffn_w_gate'][i], prm['ffn_w_up'][i], prm['ffn_w_down'][i])
        x = x + per_layer_embed(x, p[i], prm['g_ple'][i], prm['ple_w_in'][i], prm['ple_w_gate'][i])
    return rmsnorm(x, prm['g_final']), jnp.stack(pool_new), jnp.stack(re_new), jnp.stack(im_new)


def setup_inputs(seed: int = 0) -> dict:
    key = jax.random.key(seed)
    ks = jax.random.split(key, 32)
    f32 = jnp.float32

    def nrm(k, shape, s):
        return jax.random.normal(k, shape, f32) * s

    lam_im_base = jnp.pi * jnp.arange(SSM_STATE, dtype=f32)
    return {
        'x_prompt': nrm(ks[0], (BATCH, SEQ, D_MODEL), 1.0),
        'x_sample': nrm(ks[1], (DEC_BATCH, DEC_SEQ, D_MODEL), 1.0),
        'state_pool': nrm(ks[2], (N_POOL_LAYERS, DEC_BATCH, POOL_BUF, D_MODEL), 1.0),
        'state_ssm_re': nrm(ks[3], (N_SSM_LAYERS, DEC_BATCH, SSM_GROUPS, SSM_STATE), 0.1),
        'state_ssm_im': nrm(ks[4], (N_SSM_LAYERS, DEC_BATCH, SSM_GROUPS, SSM_STATE), 0.1),
        'p_prompt': nrm(ks[5], (DEPTH, BATCH, SEQ, PLE_DIM), 1.0),
        'p_sample': nrm(ks[6], (DEPTH, DEC_BATCH, DEC_SEQ, PLE_DIM), 1.0),
        'g_mix': 1.0 + nrm(ks[7], (DEPTH, D_MODEL), 0.05),
        'g_ffn': 1.0 + nrm(ks[8], (DEPTH, D_MODEL), 0.05),
        'g_ple': 1.0 + nrm(ks[9], (DEPTH, D_MODEL), 0.05),
        'g_final': 1.0 + nrm(ks[10], (D_MODEL,), 0.05),
        'pool_w': nrm(ks[11], (N_POOL_LAYERS, N_POOL_GROUPS, POOL_GROUP_DIM, POOL_GROUP_DIM), POOL_GROUP_DIM ** -0.5),
        'pool_scale': 1.0 + nrm(ks[12], (N_POOL_LAYERS, D_MODEL), 0.1),
        'ssm_lambda_re': -0.5 + nrm(ks[13], (N_SSM_LAYERS, SSM_GROUPS, SSM_STATE), 0.01),
        'ssm_lambda_im': lam_im_base + nrm(ks[14], (N_SSM_LAYERS, SSM_GROUPS, SSM_STATE), 0.01),
        'ssm_log_dt': jax.random.uniform(ks[15], (N_SSM_LAYERS, SSM_GROUPS), f32, math.log(1e-3), math.log(1e-1)),
        'ssm_b_re': nrm(ks[16], (N_SSM_LAYERS, SSM_GROUPS, SSM_STATE, SSM_GROUP_DIM), (2 * SSM_GROUP_DIM) ** -0.5),
        'ssm_b_im': nrm(ks[17], (N_SSM_LAYERS, SSM_GROUPS, SSM_STATE, SSM_GROUP_DIM), (2 * SSM_GROUP_DIM) ** -0.5),
        'ssm_c_re': nrm(ks[18], (N_SSM_LAYERS, SSM_GROUPS, SSM_GROUP_DIM, SSM_STATE), SSM_STATE ** -0.5),
        'ssm_c_im': nrm(ks[19], (N_SSM_LAYERS, SSM_GROUPS, SSM_GROUP_DIM, SSM_STATE), SSM_STATE ** -0.5),
        'ssm_d': 1.0 + nrm(ks[20], (N_SSM_LAYERS, D_MODEL), 0.1),
        'ssm_w_glu': nrm(ks[21], (N_SSM_LAYERS, D_MODEL, 2 * D_MODEL), D_MODEL ** -0.5),
        'ffn_w_gate': nrm(ks[22], (DEPTH, D_MODEL, D_FF), D_MODEL ** -0.5),
        'ffn_w_up': nrm(ks[23], (DEPTH, D_MODEL, D_FF), D_MODEL ** -0.5),
        'ffn_w_down': nrm(ks[24], (DEPTH, D_FF, D_MODEL), D_FF ** -0.5),
        'ple_w_in': nrm(ks[25], (DEPTH, PLE_DIM, D_MODEL), PLE_DIM ** -0.5),
        'ple_w_gate': nrm(ks[26], (DEPTH, D_MODEL, D_MODEL), D_MODEL ** -0.5),
    }


def reference(x_prompt, x_sample, state_pool, state_ssm_re, state_ssm_im, p_prompt, p_sample,
              g_mix, g_ffn, g_ple, g_final, pool_w, pool_scale,
              ssm_lambda_re, ssm_lambda_im, ssm_log_dt, ssm_b_re, ssm_b_im, ssm_c_re, ssm_c_im,
              ssm_d, ssm_w_glu, ffn_w_gate, ffn_w_up, ffn_w_down, ple_w_in, ple_w_gate):
    prm = dict(g_mix=g_mix, g_ffn=g_ffn, g_ple=g_ple, g_final=g_final, pool_w=pool_w, pool_scale=pool_scale,
               ssm_lambda_re=ssm_lambda_re, ssm_lambda_im=ssm_lambda_im, ssm_log_dt=ssm_log_dt,
               ssm_b_re=ssm_b_re, ssm_b_im=ssm_b_im, ssm_c_re=ssm_c_re, ssm_c_im=ssm_c_im,
               ssm_d=ssm_d, ssm_w_glu=ssm_w_glu, ffn_w_gate=ffn_w_gate, ffn_w_up=ffn_w_up,
               ffn_w_down=ffn_w_down, ple_w_in=ple_w_in, ple_w_gate=ple_w_gate)
    pool0 = jnp.zeros((N_POOL_LAYERS, x_prompt.shape[0], POOL_BUF, D_MODEL), x_prompt.dtype)
    ssm0 = jnp.zeros((N_SSM_LAYERS, x_prompt.shape[0], SSM_GROUPS, SSM_STATE), state_ssm_re.dtype)
    y_prompt, pool_prompt, ssm_re_prompt, ssm_im_prompt = run_trunk(
        x_prompt, p_prompt, 0, pool0, ssm0, ssm0, prm)
    y_sample, pool_sample, ssm_re_sample, ssm_im_sample = run_trunk(
        x_sample, p_sample, PAST_LEN, state_pool, state_ssm_re, state_ssm_im, prm)
    return (y_prompt, y_sample, pool_prompt, pool_sample, ssm_re_prompt, ssm_im_prompt, ssm_re_sample, ssm_im_sample)
```

```cpp
#include <hip/hip_runtime.h>
#include <cstdio>
#include <cstdint>

#ifndef MK_PER_PHASE
#define MK_PER_PHASE 0
#endif

#define LAS __attribute__((address_space(3)))
#define GAS __attribute__((address_space(1)))
typedef unsigned short bf16_t;
typedef short bf16x8 __attribute__((ext_vector_type(8)));
typedef float f32x4 __attribute__((ext_vector_type(4)));
typedef float f32x16 __attribute__((ext_vector_type(16)));
typedef unsigned u32x4 __attribute__((ext_vector_type(4)));
typedef unsigned u32x2 __attribute__((ext_vector_type(2)));
typedef float f32x2 __attribute__((ext_vector_type(2)));

constexpr int D = 1024, FF = 2816, PLE = 256;
constexpr int NPROMPT = 8 * 2048, NSAMPLE = 128 * 8, M = NPROMPT + NSAMPLE;
constexpr int NT = M / 256;
constexpr float EPS = 1e-6f;
constexpr int LDACT = FF;

constexpr size_t MiB = 1u << 20;
constexpr size_t WS_CTL = 0, CTL_ZERO_BYTES = 1 * MiB;
constexpr size_t WS_POOLW = 1 * MiB;
constexpr size_t WS_WGU = 2 * MiB;
constexpr size_t WS_WD = 24 * MiB;
constexpr size_t WS_WPG = 35 * MiB;
constexpr size_t WS_WPI = 39 * MiB;
constexpr size_t WS_WGLU = 40 * MiB;
constexpr size_t WS_SSMM = 44 * MiB;
constexpr size_t WS_LB = 50 * MiB;
constexpr size_t WS_E = 51 * MiB;
constexpr size_t WS_ROWSS = 54 * MiB;
constexpr size_t WS_PB = 67 * MiB;
constexpr size_t WS_XB = 84 * MiB;
constexpr size_t WS_ACT = 118 * MiB;
constexpr size_t WS_END = 212 * MiB;
static_assert(WS_ACT + (size_t)M * FF * 2 <= WS_END, "ws map");
static_assert(WS_XB + (size_t)M * D * 2 <= WS_ACT, "ws map");
static_assert(WS_PB + (size_t)2 * M * PLE * 2 <= WS_XB, "ws map");
static_assert(WS_ROWSS + (size_t)6 * M * 32 * 4 <= WS_PB, "ws map");
static_assert(WS_E + (size_t)NT * 64 * 128 * 4 <= WS_ROWSS, "ws map");
constexpr size_t ROWSS_STRIDE = (size_t)M * 32;
constexpr int CW_BAR = 4096;

constexpr size_t OUT_Y = 0;
constexpr size_t OUT_POOLP = (size_t)M * D;
constexpr size_t OUT_POOLS = OUT_POOLP + (size_t)8 * 15 * D;
constexpr size_t OUT_SREP = OUT_POOLS + (size_t)128 * 15 * D;
constexpr size_t OUT_SIMP = OUT_SREP + (size_t)8 * 64 * 64;
constexpr size_t OUT_SRES = OUT_SIMP + (size_t)8 * 64 * 64;
constexpr size_t OUT_SIMS = OUT_SRES + (size_t)128 * 64 * 64;
constexpr size_t OUT_TOTAL = OUT_SIMS + (size_t)128 * 64 * 64;

constexpr int RING_OFF = 0, RING_BYTES = 131072;
constexpr int RS_OFF = RING_BYTES;
constexpr int MISC_OFF = RS_OFF + 2048;
constexpr int LDS_BYTES = 147456;
constexpr int NWAVES = 8;

#define RLX_AGENT __ATOMIC_RELAXED, __HIP_MEMORY_SCOPE_AGENT
#define LDS_WAIT() asm volatile("s_waitcnt lgkmcnt(0)" ::: "memory")
#define VM_WAIT() asm volatile("s_waitcnt vmcnt(0)" ::: "memory")
__device__ __forceinline__ unsigned f2bf(float f) { unsigned u = __builtin_bit_cast(unsigned, f); return (u + 0x7fffu + ((u >> 16) & 1u)) >> 16; }
__device__ __forceinline__ unsigned pk2(float lo, float hi) { return f2bf(lo) | (f2bf(hi) << 16); }
__device__ __forceinline__ unsigned cvt_pk_bf16(float lo, float hi) { unsigned r; asm volatile("v_cvt_pk_bf16_f32 %0, %1, %2" : "=v"(r) : "v"(lo), "v"(hi)); return r; }
__device__ __forceinline__ float bf_lo(unsigned w) { return __builtin_bit_cast(float, w << 16); }
__device__ __forceinline__ float bf_hi(unsigned w) { return __builtin_bit_cast(float, w & 0xffff0000u); }
__device__ __forceinline__ float wave_sum(float v) {
#pragma unroll
    for (int o = 1; o < 64; o <<= 1) v += __shfl_xor(v, o);
    return v;
}
__device__ __forceinline__ int opaque_tid() { int t = threadIdx.x; asm volatile("" : "+v"(t)); return t; }
__device__ __forceinline__ float sigmoidf_(float x) { return 1.0f / (1.0f + __expf(-x)); }
__device__ __forceinline__ float sq4(f32x4 v) { return (v[0] * v[0] + v[1] * v[1]) + (v[2] * v[2] + v[3] * v[3]); }

namespace pg8 {
constexpr int BM = 256, BK = 64, HALF = 128, HTB = HALF * BK * 2  ;
__host__ __device__ __forceinline__ int lds_byte(int r, int c) { const int st = (r >> 4) * 2 + (c >> 5), rr = r & 15, cc = c & 31, ob = rr * 64 + cc * 2; return st * 1024 + (ob ^ (((ob >> 9) & 1) << 5)); }
__host__ __device__ __forceinline__ void stage_rc(int b, int& R, int& C) { const int st = b / 1024, sb = b % 1024, swz = sb ^ (((sb >> 9) & 1) << 5); R = (st >> 1) * 16 + swz / 64; C = (st & 1) * 32 + (swz % 64) / 2; }
__host__ __device__ __forceinline__ int perm32(int rho) { const int n = rho >> 4, i = rho & 15; return 8 * (i >> 2) + 4 * n + (i & 3); }

struct Unit { int pm, pn; };

struct Prob {
    const char* A; const char* Bt;
    int lda, ldb, K;
    int nN, nUnits;
    int acol;
    const float* rowss; int nparts;
    LAS float* rs;
    int c, G;
    __device__ __forceinline__ bool next(int i, Unit& u) const { const int L = i * G + c; if (L >= nUnits) return false; u.pm = L / nN; u.pn = L - u.pm * nN; return true; }
    __device__ __forceinline__ const char* a_base(const Unit& u) const { return A + ((size_t)u.pm * BM * lda + (size_t)u.pn * acol) * 2; }
    __device__ __forceinline__ const char* b_base(const Unit& u) const { return Bt + (size_t)u.pn * BM * ldb * 2; }
    __device__ __forceinline__ void a_ready(const Unit& u, int ui, int tid) const {
        if (rowss != nullptr && tid < 256) {
            const f32x4* p = (const f32x4*)(rowss + (size_t)(u.pm * BM + tid) * 32);
            float s = 0.f;
            for (int j = 0; j < nparts / 4; ++j) { const f32x4 v = p[j]; s += (v[0] + v[1]) + (v[2] + v[3]); }
            rs[(ui & 1) * 256 + tid] = __builtin_amdgcn_rsqf(s * (1.0f / D) + EPS);
        }
    }
};

template <class Epi>
__device__ __forceinline__ void gemm_phase(LAS unsigned char* lds, const Prob& S, const Epi& E) {
    const int tid = opaque_tid(), wid = __builtin_amdgcn_readfirstlane(tid >> 6), lane = tid & 63, wr = wid >> 2, wc = wid & 3, fr = lane & 15, fq = lane >> 4;
    const int K = S.K, nt = K / BK;
    unsigned voffA[2], voffB[2];
#pragma unroll
    for (int i = 0; i < 2; ++i) { int R, C; stage_rc(tid * 16 + i * 8192, R, C); const int Rb = (R & ~31) + perm32(R & 31);
        voffA[i] = (unsigned)(R * S.lda + C) * 2u; voffB[i] = (unsigned)(Rb * S.ldb + C) * 2u; }
    const size_t kstep = (size_t)(BK * 2);
    const size_t hstepA = (size_t)HALF * S.lda * 2, hstepB = (size_t)HALF * S.ldb * 2;
    const unsigned ldsw = (unsigned)wid * 1024u;
    const int aoff = lds_byte(wr * 64 + fr, fq * 8), boff = lds_byte(wc * 32 + fr, fq * 8);
#define PG8_SA(b, h) (((b) * 2 + (h)) * HTB)
#define PG8_SB(b, h) ((4 + (b) * 2 + (h)) * HTB)
#define PG8_STAGE(bufoff, gbase, voff) do { _Pragma("unroll") for (int _i = 0; _i < 2; ++_i) \
        __builtin_amdgcn_global_load_lds((const unsigned*)((const char*)(gbase) + (voff)[_i]), (LAS unsigned*)(lds + (bufoff) + ldsw + _i * 8192), 16, 0, 0); } while (0)
#define PG8_LDA(dst, b, h) do { _Pragma("unroll") for (int m = 0; m < 4; ++m) _Pragma("unroll") for (int k = 0; k < 2; ++k) dst[m][k] = *(const LAS bf16x8*)(lds + PG8_SA(b, h) + aoff + m * 2048 + k * 1024); } while (0)
#define PG8_LDB(dst, b, h) do { _Pragma("unroll") for (int n = 0; n < 2; ++n) _Pragma("unroll") for (int k = 0; k < 2; ++k) dst[n][k] = *(const LAS bf16x8*)(lds + PG8_SB(b, h) + boff + n * 2048 + k * 1024); } while (0)
#define PG8_MMA(ai, bj, At, Bt) do { __builtin_amdgcn_s_setprio(1); _Pragma("unroll") for (int m = 0; m < 4; ++m) _Pragma("unroll") for (int n = 0; n < 2; ++n) _Pragma("unroll") for (int k = 0; k < 2; ++k) \
        acc[ai][bj][m][n] = __builtin_amdgcn_mfma_f32_16x16x32_bf16(Bt[n][k], At[m][k], acc[ai][bj][m][n], 0, 0, 0); __builtin_amdgcn_s_setprio(0); } while (0)
#define PG8_WAIT_V(n) asm volatile("s_waitcnt vmcnt(" #n ")" ::: "memory")
#define PG8_WAIT_L(n) asm volatile("s_waitcnt lgkmcnt(" #n ")" ::: "memory")
#define PG8_BAR __builtin_amdgcn_s_barrier()
#define PG8_SCHED __builtin_amdgcn_sched_barrier(0)
    Unit cur, nxt; int ui = 0;
    if (!S.next(0, cur)) return;
    f32x4 acc[2][2][4][2];
#pragma unroll
    for (int a = 0; a < 2; ++a)
#pragma unroll
        for (int b = 0; b < 2; ++b)
#pragma unroll
            for (int m = 0; m < 4; ++m)
#pragma unroll
                for (int n = 0; n < 2; ++n) acc[a][b][m][n] = (f32x4){0.f, 0.f, 0.f, 0.f};
    bf16x8 At[4][2], B0[2][2], B1[2][2];
    const char* cA = S.a_base(cur); const char* cB = S.b_base(cur);
    S.a_ready(cur, 0, tid);
    PG8_STAGE(PG8_SB(0, 0), cB, voffB); PG8_STAGE(PG8_SB(0, 1), cB + hstepB, voffB); PG8_STAGE(PG8_SA(0, 0), cA, voffA); PG8_STAGE(PG8_SA(0, 1), cA + hstepA, voffA);
    if (wr == 1) PG8_BAR;
    PG8_WAIT_V(2); PG8_BAR;
    PG8_STAGE(PG8_SB(1, 0), cB + kstep, voffB); PG8_STAGE(PG8_SA(1, 0), cA + kstep, voffA); PG8_STAGE(PG8_SB(1, 1), cB + hstepB + kstep, voffB);
    PG8_WAIT_V(6); PG8_BAR;
    for (;;) {
        const bool has_next = S.next(ui + 1, nxt);
        const char* nA = has_next ? S.a_base(nxt) : cA; const char* nB = has_next ? S.b_base(nxt) : cB;
        for (int t = 0; t < nt; t += 2) {
            const bool last = (t == nt - 2);
            const char* a1 = cA + (size_t)(t + 1) * kstep;
            const char* a2 = last ? nA : cA + (size_t)(t + 2) * kstep; const char* b2 = last ? nB : cB + (size_t)(t + 2) * kstep;
            const char* a3 = a2 + kstep; const char* b3 = b2 + kstep;
            if (last && has_next) S.a_ready(nxt, ui + 1, tid);
            PG8_LDB(B0, 0, 0); PG8_LDB(B1, 0, 1); PG8_SCHED; PG8_LDA(At, 0, 0); PG8_STAGE(PG8_SA(1, 1), a1 + hstepA, voffA);
            PG8_WAIT_V(8); PG8_WAIT_L(0); PG8_BAR; PG8_MMA(0, 0, At, B0); PG8_MMA(0, 1, At, B1); PG8_BAR; PG8_SCHED;
            PG8_LDA(At, 0, 1); PG8_STAGE(PG8_SB(0, 0), b2, voffB); PG8_STAGE(PG8_SB(0, 1), b2 + hstepB, voffB); PG8_STAGE(PG8_SA(0, 0), a2, voffA);
            PG8_WAIT_V(8); PG8_WAIT_L(0); PG8_BAR; PG8_MMA(1, 0, At, B0); PG8_MMA(1, 1, At, B1); PG8_BAR; PG8_SCHED;
            PG8_LDB(B0, 1, 0); PG8_LDB(B1, 1, 1); PG8_SCHED; PG8_LDA(At, 1, 0); PG8_STAGE(PG8_SA(0, 1), a2 + hstepA, voffA);
            PG8_WAIT_V(8); PG8_WAIT_L(0); PG8_BAR; PG8_MMA(0, 0, At, B0); PG8_MMA(0, 1, At, B1); PG8_BAR; PG8_SCHED;
            PG8_LDA(At, 1, 1); PG8_STAGE(PG8_SB(1, 0), b3, voffB); PG8_STAGE(PG8_SB(1, 1), b3 + hstepB, voffB); PG8_STAGE(PG8_SA(1, 0), a3, voffA);
            PG8_WAIT_V(8); PG8_WAIT_L(0); PG8_BAR; PG8_MMA(1, 0, At, B0); PG8_MMA(1, 1, At, B1); PG8_BAR; PG8_SCHED;
        }
        if (wr == 0) PG8_BAR;
        E(acc, cur, ui, wr, wc, fr, fq);
        if (!has_next) break;
#pragma unroll
        for (int a = 0; a < 2; ++a)
#pragma unroll
            for (int b = 0; b < 2; ++b)
#pragma unroll
                for (int m = 0; m < 4; ++m)
#pragma unroll
                    for (int n = 0; n < 2; ++n) acc[a][b][m][n] = (f32x4){0.f, 0.f, 0.f, 0.f};
        cur = nxt; cA = nA; cB = nB; ++ui;
        if (wr == 1) PG8_BAR;
    }
    PG8_WAIT_V(0);
    PG8_BAR;
#undef PG8_SA
#undef PG8_SB
#undef PG8_STAGE
#undef PG8_LDA
#undef PG8_LDB
#undef PG8_MMA
#undef PG8_WAIT_V
#undef PG8_WAIT_L
#undef PG8_BAR
#undef PG8_SCHED
}

typedef const f32x4 (&AccRef)[2][2][4][2];

struct EpiPool {
    const float* xp; const float* xs; float* X; bf16_t* XB; const float* scale; float* rowss;
    __device__ __forceinline__ void operator()(AccRef acc, const Unit& u, int ui, int wr, int wc, int fr, int fq) const {
        const int row0 = u.pm * BM + wr * 64 + fr, col0 = u.pn * BM + wc * 32 + 8 * fq;
        const float* xin = (u.pm < 64) ? xp : (xs - (size_t)NPROMPT * D);
        f32x4 sc[2][2];
#pragma unroll
        for (int bj = 0; bj < 2; ++bj)
#pragma unroll
            for (int n = 0; n < 2; ++n) sc[bj][n] = *(const f32x4*)(scale + col0 + bj * HALF + 4 * n);
#pragma unroll
        for (int ai = 0; ai < 2; ++ai)
#pragma unroll
            for (int m = 0; m < 4; ++m) { const size_t row = (size_t)(row0 + ai * HALF + m * 16); float ssq = 0.f;
#pragma unroll
                for (int bj = 0; bj < 2; ++bj) { const size_t off = row * D + col0 + bj * HALF;
                    const f32x4 v0 = *(const f32x4*)(xin + off) + sc[bj][0] * acc[ai][bj][m][0], v1 = *(const f32x4*)(xin + off + 4) + sc[bj][1] * acc[ai][bj][m][1];
                    *(f32x4*)(X + off) = v0; *(f32x4*)(X + off + 4) = v1; ssq += sq4(v0) + sq4(v1);
                    u32x4 w; w.x = cvt_pk_bf16(v0[0], v0[1]); w.y = cvt_pk_bf16(v0[2], v0[3]); w.z = cvt_pk_bf16(v1[0], v1[1]); w.w = cvt_pk_bf16(v1[2], v1[3]);
                    *(u32x4*)(XB + off) = w; }
                ssq += __shfl_xor(ssq, 16); ssq += __shfl_xor(ssq, 32);
                if (fq == 0) rowss[row * 32 + u.pn * 4 + wc] = ssq; }
    }
};
struct EpiGateUp {
    bf16_t* ACT; const LAS float* rs;
    __device__ __forceinline__ void operator()(AccRef acc, const Unit& u, int ui, int wr, int wc, int fr, int fq) const {
        const int row0 = u.pm * BM + wr * 64 + fr, col0 = u.pn * HALF + wc * 32 + 8 * fq;
#pragma unroll
        for (int ai = 0; ai < 2; ++ai)
#pragma unroll
            for (int m = 0; m < 4; ++m) { const float r = rs[(ui & 1) * 256 + ai * HALF + wr * 64 + m * 16 + fr];
                float a[8];
#pragma unroll
                for (int n = 0; n < 2; ++n)
#pragma unroll
                    for (int e = 0; e < 4; ++e) { const float g = r * acc[ai][0][m][n][e], up = r * acc[ai][1][m][n][e]; a[n * 4 + e] = g * sigmoidf_(g) * up; }
                u32x4 w; w.x = cvt_pk_bf16(a[0], a[1]); w.y = cvt_pk_bf16(a[2], a[3]); w.z = cvt_pk_bf16(a[4], a[5]); w.w = cvt_pk_bf16(a[6], a[7]);
                *(u32x4*)(ACT + (size_t)(row0 + ai * HALF + m * 16) * LDACT + col0) = w; }
    }
};
struct EpiDown {
    float* X; bf16_t* XB; float* rowss;
    __device__ __forceinline__ void operator()(AccRef acc, const Unit& u, int ui, int wr, int wc, int fr, int fq) const {
        const int row0 = u.pm * BM + wr * 64 + fr, col0 = u.pn * BM + wc * 32 + 8 * fq;
#pragma unroll
        for (int ai = 0; ai < 2; ++ai)
#pragma unroll
            for (int m = 0; m < 4; ++m) { const size_t row = (size_t)(row0 + ai * HALF + m * 16); float ssq = 0.f;
#pragma unroll
                for (int bj = 0; bj < 2; ++bj) { const size_t off = row * D + col0 + bj * HALF;
                    const f32x4 v0 = *(const f32x4*)(X + off) + acc[ai][bj][m][0], v1 = *(const f32x4*)(X + off + 4) + acc[ai][bj][m][1];
                    *(f32x4*)(X + off) = v0; *(f32x4*)(X + off + 4) = v1; ssq += sq4(v0) + sq4(v1);
                    u32x4 w; w.x = cvt_pk_bf16(v0[0], v0[1]); w.y = cvt_pk_bf16(v0[2], v0[3]); w.z = cvt_pk_bf16(v1[0], v1[1]); w.w = cvt_pk_bf16(v1[2], v1[3]);
                    *(u32x4*)(XB + off) = w; }
                ssq += __shfl_xor(ssq, 16); ssq += __shfl_xor(ssq, 32);
                if (fq == 0) rowss[row * 32 + u.pn * 4 + wc] = ssq; }
    }
};
struct EpiT {
    bf16_t* T;
    __device__ __forceinline__ void operator()(AccRef acc, const Unit& u, int ui, int wr, int wc, int fr, int fq) const {
        const int row0 = u.pm * BM + wr * 64 + fr, col0 = u.pn * BM + wc * 32 + 8 * fq;
#pragma unroll
        for (int ai = 0; ai < 2; ++ai)
#pragma unroll
            for (int m = 0; m < 4; ++m)
#pragma unroll
                for (int bj = 0; bj < 2; ++bj) { const f32x4 v0 = acc[ai][bj][m][0], v1 = acc[ai][bj][m][1];
                    u32x4 w; w.x = cvt_pk_bf16(v0[0], v0[1]); w.y = cvt_pk_bf16(v0[2], v0[3]); w.z = cvt_pk_bf16(v1[0], v1[1]); w.w = cvt_pk_bf16(v1[2], v1[3]);
                    *(u32x4*)(T + (size_t)(row0 + ai * HALF + m * 16) * LDACT + col0 + bj * HALF) = w; }
    }
};
struct EpiPle {
    float* X; const bf16_t* T; float* rowss; const LAS float* rs;
    __device__ __forceinline__ void operator()(AccRef acc, const Unit& u, int ui, int wr, int wc, int fr, int fq) const {
        const int row0 = u.pm * BM + wr * 64 + fr, col0 = u.pn * BM + wc * 32 + 8 * fq;
#pragma unroll
        for (int ai = 0; ai < 2; ++ai)
#pragma unroll
            for (int m = 0; m < 4; ++m) { const size_t row = (size_t)(row0 + ai * HALF + m * 16); float ssq = 0.f;
                const float r = rs[(ui & 1) * 256 + ai * HALF + wr * 64 + m * 16 + fr];
#pragma unroll
                for (int bj = 0; bj < 2; ++bj) { const size_t off = row * D + col0 + bj * HALF;
                    const u32x4 tw = *(const u32x4*)(T + row * LDACT + col0 + bj * HALF);
                    const f32x4 a0 = acc[ai][bj][m][0], a1 = acc[ai][bj][m][1];
                    f32x4 g0, g1;
#pragma unroll
                    for (int e = 0; e < 4; ++e) { g0[e] = sigmoidf_(r * a0[e]); g1[e] = sigmoidf_(r * a1[e]); }
                    const f32x4 t0 = (f32x4){bf_lo(tw.x), bf_hi(tw.x), bf_lo(tw.y), bf_hi(tw.y)}, t1 = (f32x4){bf_lo(tw.z), bf_hi(tw.z), bf_lo(tw.w), bf_hi(tw.w)};
                    const f32x4 v0 = *(const f32x4*)(X + off) + t0 * g0, v1 = *(const f32x4*)(X + off + 4) + t1 * g1;
                    *(f32x4*)(X + off) = v0; *(f32x4*)(X + off + 4) = v1; ssq += sq4(v0) + sq4(v1); }
                ssq += __shfl_xor(ssq, 16); ssq += __shfl_xor(ssq, 32);
                if (fq == 0) rowss[row * 32 + u.pn * 4 + wc] = ssq; }
    }
};
struct EpiGlu {
    float* X; bf16_t* XB; float* rowss;
    __device__ __forceinline__ void operator()(AccRef acc, const Unit& u, int ui, int wr, int wc, int fr, int fq) const {
        const int row0 = u.pm * BM + wr * 64 + fr, col0 = u.pn * HALF + wc * 32 + 8 * fq;
#pragma unroll
        for (int ai = 0; ai < 2; ++ai)
#pragma unroll
            for (int m = 0; m < 4; ++m) { const size_t row = (size_t)(row0 + ai * HALF + m * 16); const size_t off = row * D + col0;
                f32x4 g0, g1;
#pragma unroll
                for (int e = 0; e < 4; ++e) { g0[e] = sigmoidf_(acc[ai][1][m][0][e]); g1[e] = sigmoidf_(acc[ai][1][m][1][e]); }
                const f32x4 v0 = *(const f32x4*)(X + off) + acc[ai][0][m][0] * g0, v1 = *(const f32x4*)(X + off + 4) + acc[ai][0][m][1] * g1;
                *(f32x4*)(X + off) = v0; *(f32x4*)(X + off + 4) = v1; float ssq = sq4(v0) + sq4(v1);
                u32x4 w; w.x = cvt_pk_bf16(v0[0], v0[1]); w.y = cvt_pk_bf16(v0[2], v0[3]); w.z = cvt_pk_bf16(v1[0], v1[1]); w.w = cvt_pk_bf16(v1[2], v1[3]);
                *(u32x4*)(XB + off) = w;
                ssq += __shfl_xor(ssq, 16); ssq += __shfl_xor(ssq, 32);
                if (fq == 0) rowss[row * 32 + u.pn * 4 + wc] = ssq; }
    }
};
}

#define XB_TMO      128
#define XB_XCNT(j)  (256  + 64 * (j))
#define XB_XSUB(j)  (1280 + 64 * (j))
#define XB_XGEN(j)  (2304 + 64 * (j))
#define XB_TOP      3328
#define XB_TOPGEN   3392
#define XCD_BAR_WORDS 3456
#define XB_SPIN_CAP (1u << 18)
__device__ __forceinline__ unsigned xb_ld(unsigned* p)              { return __hip_atomic_load(p, __ATOMIC_RELAXED, __HIP_MEMORY_SCOPE_AGENT); }
__device__ __forceinline__ unsigned xb_add(unsigned* p, unsigned v) { return __hip_atomic_fetch_add(p, v, __ATOMIC_RELAXED, __HIP_MEMORY_SCOPE_AGENT); }
__device__ __forceinline__ unsigned xb_xcc_id() { return (unsigned)__builtin_amdgcn_s_getreg((3 << 11) | 20) & 0xFu; }
#define XB_SPIN(cond, bar) do { unsigned _sp = 0; while (cond) { __builtin_amdgcn_s_sleep(1); \
    if ((++_sp & 255u) == 0u) { if (xb_ld(&(bar)[XB_TMO])) break; if (_sp > XB_SPIN_CAP) { atomicAdd(&(bar)[XB_TMO], 1u); break; } } } } while (0)
struct XcdBarrier { unsigned* bar; unsigned x; volatile LAS unsigned* st; };
__device__ __forceinline__ XcdBarrier xcd_barrier_post(unsigned* bar, volatile LAS unsigned* st) {
    XcdBarrier b; b.bar = bar; b.x = xb_xcc_id(); b.st = st;
    if (threadIdx.x == 0) (void)xb_add(&bar[XB_XCNT(b.x)], 1u);
    return b;
}
__device__ __forceinline__ void xcd_barrier_complete(unsigned* bar, unsigned x, unsigned& nloc, unsigned& nx) {
    const unsigned G = gridDim.x * gridDim.y * gridDim.z;
    unsigned sum, cnt, mine, sp = 0u;
    for (;;) {
        sum = 0u; cnt = 0u; mine = 0u;
#pragma unroll
        for (unsigned j = 0; j < 16; ++j) { const unsigned c = xb_ld(&bar[XB_XCNT(j)]); sum += c; cnt += (c > 0u) ? 1u : 0u; mine = (j == x) ? c : mine; }
        if (sum == G) break;
        __builtin_amdgcn_s_sleep(1);
        if ((++sp & 255u) == 0u) { if (xb_ld(&bar[XB_TMO])) break; if (sp > XB_SPIN_CAP) { atomicAdd(&bar[XB_TMO], 1u); break; } }
    }
    nloc = mine > 0u ? mine : 1u; nx = cnt > 0u ? cnt : 1u;
}
__device__ __forceinline__ void xcd_barrier(const XcdBarrier& b) {
    asm volatile("s_waitcnt vmcnt(0)" ::: "memory");
    __syncthreads();
    if (threadIdx.x == 0) {
        unsigned* bar = b.bar;
        __builtin_amdgcn_s_waitcnt(0);
        unsigned nloc = b.st[0], nx = b.st[1];
        if (nloc == 0u) { xcd_barrier_complete(bar, b.x, nloc, nx); b.st[0] = nloc; b.st[1] = nx; }
        const unsigned old = xb_add(&bar[XB_XSUB(b.x)], 1u);
        const unsigned gen = old / nloc;
        if (old + 1u == (gen + 1u) * nloc) {
            __builtin_amdgcn_fence(__ATOMIC_RELEASE, "agent");
            asm volatile("s_waitcnt vmcnt(0)" ::: "memory");
            const unsigned og = xb_add(&bar[XB_TOP], 1u);
            const unsigned tg = og / nx;
            if (og + 1u == (tg + 1u) * nx) xb_add(&bar[XB_TOPGEN], 1u);
            else XB_SPIN(xb_ld(&bar[XB_TOPGEN]) == tg, bar);
            __builtin_amdgcn_fence(__ATOMIC_ACQUIRE, "agent");
            xb_add(&bar[XB_XGEN(b.x)], 1u);
            asm volatile("s_waitcnt vmcnt(0)" ::: "memory");
        } else {
            XB_SPIN(xb_ld(&bar[XB_XGEN(b.x)]) == gen, bar);
            __builtin_amdgcn_fence(__ATOMIC_ACQUIRE, "agent");
            asm volatile("s_waitcnt vmcnt(0)" ::: "memory");
        }
    }
    __syncthreads();
}

struct Args {
    const float* in[27];
    float* out; unsigned char* ws;
    int ph_lo, ph_hi, li, pad;
};
struct Frame {
    LAS unsigned char* lds; int tid, lane, wave, vcu, G;
    const Args* a;
};

__device__ __forceinline__ void p0_transpose_item(const float* W, int ldw, int coff, int Nsub, int K, bf16_t* WT, const float* gs, int interleave, int half, LAS float* scr, int item, int lane) {
    const int nblk = Nsub / 32, kb = item / nblk, nb = item % nblk, k0 = 64 * kb, n0 = 32 * nb;
#pragma unroll 8
    for (int i = 0; i < 32; ++i) { const int kk = 2 * i + (lane >> 5); float v = W[(size_t)(k0 + kk) * ldw + coff + n0 + (lane & 31)]; if (gs) v *= gs[k0 + kk]; scr[kk * 33 + (lane & 31)] = v; }
    LDS_WAIT(); asm volatile("" ::: "memory");
    const int c = lane & 7;
#pragma unroll
    for (int j = 0; j < 4; ++j) { const int nl = (lane >> 3) + 8 * j, n = n0 + nl; const LAS float* s = scr + (8 * c) * 33 + nl;
        const int orow = interleave ? ((n >> 7) * 256 + half * 128 + (n & 127)) : n;
        u32x4 o; o.x = pk2(s[0 * 33], s[1 * 33]); o.y = pk2(s[2 * 33], s[3 * 33]); o.z = pk2(s[4 * 33], s[5 * 33]); o.w = pk2(s[6 * 33], s[7 * 33]);
        *(u32x4*)(WT + (size_t)orow * K + k0 + 8 * c) = o; }
    LDS_WAIT(); asm volatile("" ::: "memory");
}

__device__ __forceinline__ void sincos_d(double x, double& s, double& c) {
    const double k = __builtin_rint(x * 0.63661977236758134308);
    double r = __builtin_fma(-k, 1.57079632679489655800e+00, x);
    r = __builtin_fma(-k, 6.12323399573676603587e-17, r);
    const double r2 = r * r;
    double sp = -7.6471637318198164759e-13;
    sp = sp * r2 + 1.6059043836821614599e-10; sp = sp * r2 - 2.5052108385441718775e-08; sp = sp * r2 + 2.7557319223985890653e-06;
    sp = sp * r2 - 1.9841269841269841270e-04; sp = sp * r2 + 8.3333333333333333333e-03; sp = sp * r2 - 1.6666666666666666667e-01;
    const double sr = r + r * r2 * sp;
    double cp = 4.7794773323873852974e-14;
    cp = cp * r2 - 1.1470745597729724714e-11; cp = cp * r2 + 2.0876756987868098979e-09; cp = cp * r2 - 2.7557319223985890653e-07;
    cp = cp * r2 + 2.4801587301587301587e-05; cp = cp * r2 - 1.3888888888888888889e-03; cp = cp * r2 + 4.1666666666666666667e-02; cp = cp * r2 - 0.5;
    const double cr = 1.0 + r2 * cp;
    const long long q = (long long)k & 3;
    s = (q == 0) ? sr : (q == 1) ? cr : (q == 2) ? -sr : -cr;
    c = (q == 0) ? cr : (q == 1) ? -sr : (q == 2) ? -cr : sr;
}
__device__ __forceinline__ double exp_d(double x) {
    const double n = __builtin_rint(x * 1.44269504088896340736);
    const double r = __builtin_fma(-n, 6.93147180369123816490e-01, x) - n * 1.90821492927058770002e-10;
    double p = 1.0 / 6227020800.0;
    p = p * r + 1.0 / 479001600.0; p = p * r + 1.0 / 39916800.0; p = p * r + 1.0 / 3628800.0; p = p * r + 1.0 / 362880.0; p = p * r + 1.0 / 40320.0;
    p = p * r + 1.0 / 5040.0; p = p * r + 1.0 / 720.0; p = p * r + 1.0 / 120.0; p = p * r + 1.0 / 24.0; p = p * r + 1.0 / 6.0; p = p * r + 0.5; p = p * r + 1.0; p = p * r + 1.0;
    return __builtin_ldexp(p, (int)n);
}

__device__ __forceinline__ void p0_ssm_group(const Args& a, int g, LAS float* scr, int lane) {
    const float* lam_re = a.in[13]; const float* lam_im = a.in[14]; const float* log_dt = a.in[15];
    const float* b_re = a.in[16]; const float* b_im = a.in[17]; const float* c_re = a.in[18]; const float* c_im = a.in[19];
    bf16_t* Tm = (bf16_t*)(a.ws + WS_SSMM) + (size_t)g * 16384;
    bf16_t* Bp = (bf16_t*)(a.ws + WS_SSMM + 2 * MiB) + (size_t)g * 16384;
    bf16_t* Cp = (bf16_t*)(a.ws + WS_SSMM + 4 * MiB) + (size_t)g * 16384;
    float2* lbt = (float2*)(a.ws + WS_LB);
    LAS f32x2* lbp = (LAS f32x2*)scr;
    LAS f32x2* Bb = (LAS f32x2*)(scr + 2 * 9 * 64);
    const int p = lane;
    const double dt = exp_d((double)log_dt[g]);
    const double lr = (double)lam_re[g * 64 + p], li = (double)lam_im[g * 64 + p];
    double l1r = 0.0, l1i = 0.0;
    for (int k = 0; k <= 8; ++k) { const double mag = exp_d(lr * dt * k); double s, c; sincos_d(li * dt * k, s, c); lbp[k * 64 + p] = (f32x2){(float)(mag * c), (float)(mag * s)}; if (k == 1) { l1r = mag * c; l1i = mag * s; } }
    { const double mag = exp_d(lr * dt * 8); double s, c; sincos_d(li * dt * 8, s, c); lbt[(0 * 64 + g) * 64 + p] = make_float2((float)(mag * c), (float)(mag * s)); }
    { const double mag = exp_d(lr * dt * 128); double s, c; sincos_d(li * dt * 128, s, c); lbt[(1 * 64 + g) * 64 + p] = make_float2((float)(mag * c), (float)(mag * s)); }
    { const double mag = exp_d(lr * dt * 256); double s, c; sincos_d(li * dt * 256, s, c); lbt[(2 * 64 + g) * 64 + p] = make_float2((float)(mag * c), (float)(mag * s)); }
    const double den = lr * lr + li * li;
    const double fre = ((l1r - 1.0) * lr + l1i * li) / den, fim = (l1i * lr - (l1r - 1.0) * li) / den;
    for (int i = 0; i < 16; ++i) { const double br = (double)b_re[(g * 64 + p) * 16 + i], bi = (double)b_im[(g * 64 + p) * 16 + i];
        Bb[p * 16 + i] = (f32x2){(float)(fre * br - fim * bi), (float)(fre * bi + fim * br)}; }
    LDS_WAIT(); asm volatile("" ::: "memory");
    { const int sp = lane >> 3, i0 = 2 * (lane & 7);
      for (int pp = 0; pp < 64; ++pp) { const f32x2 l = lbp[(7 - sp) * 64 + pp], b0 = Bb[pp * 16 + i0], b1 = Bb[pp * 16 + i0 + 1];
          const float r0 = l.x * b0.x - l.y * b0.y, m0 = l.x * b0.y + l.y * b0.x, r1 = l.x * b1.x - l.y * b1.y, m1 = l.x * b1.y + l.y * b1.x;
          *(unsigned*)(Bp + (size_t)pp * 128 + 2 * lane) = pk2(r0, r1); *(unsigned*)(Bp + (size_t)(64 + pp) * 128 + 2 * lane) = pk2(m0, m1); } }
    for (int s = 0; s < 8; ++s) { const f32x2 l = lbp[(s + 1) * 64 + p];
        for (int h = 0; h < 16; ++h) { const float cr = c_re[(g * 16 + h) * 64 + p], ci = c_im[(g * 16 + h) * 64 + p];
            Cp[(size_t)(s * 16 + h) * 128 + p] = (bf16_t)f2bf(cr * l.x - ci * l.y); Cp[(size_t)(s * 16 + h) * 128 + 64 + p] = (bf16_t)f2bf(-(cr * l.y + ci * l.x)); } }
    float kk[32];
#pragma unroll
    for (int m = 0; m < 32; ++m) { const int idx = lane + 64 * m, k = idx >> 8, h = (idx >> 4) & 15, i = idx & 15; float acc = 0.f;
#pragma unroll 2
        for (int pp = 0; pp < 64; ++pp) { const f32x2 l = lbp[k * 64 + pp], b = Bb[pp * 16 + i]; const float cr = c_re[(g * 16 + h) * 64 + pp], ci = c_im[(g * 16 + h) * 64 + pp];
            const float tr = l.x * b.x - l.y * b.y, ti = l.x * b.y + l.y * b.x; acc += cr * tr - ci * ti; }
        kk[m] = acc; }
    LDS_WAIT(); asm volatile("" ::: "memory");
    LAS float* Kk = (LAS float*)Bb;
#pragma unroll
    for (int m = 0; m < 32; ++m) Kk[lane + 64 * m] = kk[m];
    LDS_WAIT(); asm volatile("" ::: "memory");
    { const int sp = lane >> 3, i0 = 2 * (lane & 7);
      for (int row = 0; row < 128; ++row) { const int s = row >> 4, h = row & 15; float v0 = 0.f, v1 = 0.f;
          if (s >= sp) { v0 = Kk[((s - sp) * 16 + h) * 16 + i0]; v1 = Kk[((s - sp) * 16 + h) * 16 + i0 + 1]; }
          *(unsigned*)(Tm + (size_t)row * 128 + 2 * lane) = pk2(v0, v1); } }
    LDS_WAIT(); asm volatile("" ::: "memory");
}

__device__ __forceinline__ void p0_pool_strip(const Args& a, int s, int lane) {
    const float* gm = a.in[7];
    const bool prompt = s < 2048;
    int t0, b; size_t row0; const float* x; const float* prev = nullptr; float* pout = nullptr;
    if (prompt) { b = s >> 8; t0 = (s & 255) * 8; row0 = (size_t)b * 2048 + t0; x = a.in[0] + row0 * D; if (t0 == 2040) pout = a.out + OUT_POOLP + (size_t)b * 15 * D; }
    else { b = s - 2048; t0 = 0; row0 = (size_t)NPROMPT + (size_t)b * 8; x = a.in[1] + (size_t)b * 8 * D; prev = a.in[2] + (size_t)b * 15 * D; pout = a.out + OUT_POOLS + (size_t)b * 15 * D; }
    bf16_t* diff = (bf16_t*)(a.ws + WS_ACT) + row0 * LDACT;
    f32x4 gq[4];
#pragma unroll
    for (int j = 0; j < 4; ++j) gq[j] = *(const f32x4*)(gm + 4 * lane + 256 * j);
    f32x4 S[4][8];
#pragma unroll
    for (int j = 0; j < 4; ++j)
#pragma unroll
        for (int i = 0; i < 8; ++i) S[j][i] = (f32x4){0.f, 0.f, 0.f, 0.f};
#pragma unroll
    for (int src = -15; src < 8; ++src) {
        f32x4 hv[4];
        bool have = true;
        if (src < 0 && !prompt) {
#pragma unroll
            for (int j = 0; j < 4; ++j) hv[j] = *(const f32x4*)(prev + (size_t)(15 + src) * D + 4 * lane + 256 * j);
        } else if (src < 0 && t0 + src < 0) {
            have = false;
#pragma unroll
            for (int j = 0; j < 4; ++j) hv[j] = (f32x4){0.f, 0.f, 0.f, 0.f};
        } else {
            const float* xr = x + (ptrdiff_t)src * D;
            float ss = 0.f;
#pragma unroll
            for (int j = 0; j < 4; ++j) { hv[j] = *(const f32x4*)(xr + 4 * lane + 256 * j); ss += sq4(hv[j]); }
            const float r = 1.0f / sqrtf(wave_sum(ss) * (1.0f / D) + EPS);
#pragma unroll
            for (int j = 0; j < 4; ++j) hv[j] = hv[j] * r * gq[j];
        }
        if (have) {
#pragma unroll
            for (int j = 0; j < 4; ++j) { const int w = 2 << j;
#pragma unroll
                for (int i = 0; i < 8; ++i) if (i >= src && i <= src + w - 1) S[j][i] += hv[j]; }
        }
        if (src >= 0) {
#pragma unroll
            for (int j = 0; j < 4; ++j) { const int w = 2 << j; const int cnt = prompt ? ((t0 + src + 1) < w ? (t0 + src + 1) : w) : w;
                const f32x4 d = S[j][src] * (1.0f / (float)cnt) - hv[j];
                u32x2 o; o.x = cvt_pk_bf16(d[0], d[1]); o.y = cvt_pk_bf16(d[2], d[3]);
                *(u32x2*)(diff + (size_t)src * LDACT + 4 * lane + 256 * j) = o; }
        }
        if (src >= -7 && pout != nullptr) {
#pragma unroll
            for (int j = 0; j < 4; ++j) *(f32x4*)(pout + (size_t)(src + 7) * D + 4 * lane + 256 * j) = hv[j];
        }
    }
}

__device__ __forceinline__ void p0_prologue(Frame& F) {
    const Args& a = *F.a;
    LAS float* scr = (LAS float*)(F.lds + RING_OFF + F.wave * 16384);
    const int gw = F.vcu * NWAVES + F.wave, NGW = F.G * NWAVES;
    constexpr int I_SSM = 64, I_POOL = 2176, I_PCONV = 2 * M / 32;
    constexpr int I_G = 16 * 88, I_DN = 44 * 32, I_PG = 16 * 32, I_PI = 4 * 32, I_GLU = 16 * 32, I_PW = 4 * 8;
    constexpr int I_LAYER = 2 * I_G + I_DN + I_PG + I_PI;
    constexpr int NITEMS = I_SSM + I_POOL + I_PCONV + 2 * I_LAYER + 2 * I_GLU + 4 * I_PW;
    for (int it = gw; it < NITEMS; it += NGW) {
        int r = it;
        if (r < I_SSM) { p0_ssm_group(a, r, scr, F.lane); continue; } r -= I_SSM;
        if (r < I_POOL) { p0_pool_strip(a, r, F.lane); continue; } r -= I_POOL;
        if (r < I_PCONV) {
            const int layer = r / (M / 32), rb = r % (M / 32); const size_t rowb = (size_t)rb * 32;
            bf16_t* pb = (bf16_t*)(a.ws + WS_PB) + (size_t)layer * M * PLE + rowb * PLE;
            const float* src = (rowb < NPROMPT) ? a.in[5] + ((size_t)layer * NPROMPT + rowb) * PLE : a.in[6] + ((size_t)layer * NSAMPLE + (rowb - NPROMPT)) * PLE;
#pragma unroll 4
            for (int j = 0; j < 32; ++j) { const f32x4 v = *(const f32x4*)(src + (size_t)j * PLE + 4 * F.lane); u32x2 o; o.x = pk2(v[0], v[1]); o.y = pk2(v[2], v[3]); *(u32x2*)(pb + (size_t)j * PLE + 4 * F.lane) = o; }
            continue; }
        r -= I_PCONV;
        if (r < 2 * I_LAYER) {
            const int layer = r / I_LAYER; r %= I_LAYER;
            if (r < I_G) { p0_transpose_item(a.in[22] + (size_t)layer * D * FF, FF, 0, FF, D, (bf16_t*)(a.ws + WS_WGU) + (size_t)layer * 2 * FF * D, a.in[8] + layer * D, 1, 0, scr, r, F.lane); continue; } r -= I_G;
            if (r < I_G) { p0_transpose_item(a.in[23] + (size_t)layer * D * FF, FF, 0, FF, D, (bf16_t*)(a.ws + WS_WGU) + (size_t)layer * 2 * FF * D, a.in[8] + layer * D, 1, 1, scr, r, F.lane); continue; } r -= I_G;
            if (r < I_DN) { p0_transpose_item(a.in[24] + (size_t)layer * FF * D, D, 0, D, FF, (bf16_t*)(a.ws + WS_WD) + (size_t)layer * D * FF, nullptr, 0, 0, scr, r, F.lane); continue; } r -= I_DN;
            if (r < I_PG) { p0_transpose_item(a.in[26] + (size_t)layer * D * D, D, 0, D, D, (bf16_t*)(a.ws + WS_WPG) + (size_t)layer * D * D, a.in[9] + layer * D, 0, 0, scr, r, F.lane); continue; } r -= I_PG;
            p0_transpose_item(a.in[25] + (size_t)layer * PLE * D, D, 0, D, PLE, (bf16_t*)(a.ws + WS_WPI) + (size_t)layer * D * PLE, nullptr, 0, 0, scr, r, F.lane); continue;
        }
        r -= 2 * I_LAYER;
        if (r < 2 * I_GLU) { const int half = r / I_GLU; p0_transpose_item(a.in[21], 2 * D, half * D, D, D, (bf16_t*)(a.ws + WS_WGLU), nullptr, 1, half, scr, r % I_GLU, F.lane); continue; }
        r -= 2 * I_GLU;
        { const int gi = r / I_PW; p0_transpose_item(a.in[11] + (size_t)gi * 256 * 256, 256, 0, 256, 256, (bf16_t*)(a.ws + WS_POOLW) + (size_t)gi * 256 * 256, nullptr, 0, 0, scr, r % I_PW, F.lane); }
    }
}

__device__ __forceinline__ f32x16 zero16() { f32x16 z; for (int i = 0; i < 16; ++i) z[i] = 0.f; return z; }

template <bool S2>
__device__ __forceinline__ void ssm_item(Frame& F, int pm, int g, const LAS float* rs, LAS unsigned char* scr) {
    const Args& a = *F.a;
    const int lane = F.lane, r32 = lane & 31, hh = lane >> 5;
    const float* X = a.out + OUT_Y;
    const float* gm = a.in[7] + D;
    const int ch = (r32 & 3) + 4 * (r32 >> 3) + 16 * ((r32 >> 2) & 1);
    const bool prompt = pm < 64;
    bf16x8 au[8];
    { const f32x4 g0 = *(const f32x4*)(gm + g * 16 + 8 * hh), g1 = *(const f32x4*)(gm + g * 16 + 8 * hh + 4);
#pragma unroll
      for (int ks = 0; ks < 8; ++ks) { const int rl = 8 * ch + ks; const float* xr = X + (size_t)(pm * 256 + rl) * D + g * 16 + 8 * hh;
          const float r = rs[rl]; const f32x4 v0 = *(const f32x4*)xr * g0 * r, v1 = *(const f32x4*)(xr + 4) * g1 * r;
          u32x4 w; w.x = cvt_pk_bf16(v0[0], v0[1]); w.y = cvt_pk_bf16(v0[2], v0[3]); w.z = cvt_pk_bf16(v1[0], v1[1]); w.w = cvt_pk_bf16(v1[2], v1[3]);
          au[ks] = __builtin_bit_cast(bf16x8, w); } }
    const bf16_t* Bp = (const bf16_t*)(a.ws + WS_SSMM + 2 * MiB) + (size_t)g * 16384;
    f32x16 sl[4];
#pragma unroll
    for (int nb = 0; nb < 4; ++nb) { sl[nb] = zero16();
#pragma unroll
        for (int ks = 0; ks < 8; ++ks) { const bf16x8 bfr = *(const bf16x8*)(Bp + (size_t)(32 * nb + r32) * 128 + 16 * ks + 8 * hh);
            sl[nb] = __builtin_amdgcn_mfma_f32_32x32x16_bf16(au[ks], bfr, sl[nb], 0, 0, 0); }
        asm volatile("" ::: "memory"); }
    const float2* lbt = (const float2*)(a.ws + WS_LB);
    float2 l8[2];
#pragma unroll
    for (int nbp = 0; nbp < 2; ++nbp) l8[nbp] = lbt[(0 * 64 + g) * 64 + 32 * nbp + r32];
    if constexpr (!S2) {
        if (!prompt) return;
        float* E = (float*)(a.ws + WS_E) + ((size_t)pm * 64 + g) * 128;
#pragma unroll
        for (int nbp = 0; nbp < 2; ++nbp) { float er = 0.f, ei = 0.f;
#pragma unroll
            for (int i = 0; i < 16; ++i) { const float nr = l8[nbp].x * er - l8[nbp].y * ei + sl[nbp][i], ni = l8[nbp].x * ei + l8[nbp].y * er + sl[nbp + 2][i]; er = nr; ei = ni; }
            const float lr_ = __shfl_xor(er, 32), li_ = __shfl_xor(ei, 32);
            const float2 l128 = lbt[(1 * 64 + g) * 64 + 32 * nbp + r32];
            if (hh == 1) { E[32 * nbp + r32] = l128.x * lr_ - l128.y * li_ + er; E[64 + 32 * nbp + r32] = l128.x * li_ + l128.y * lr_ + ei; } }
        return;
    } else {
        float* ore; float* oim;
        if (prompt) { ore = a.out + OUT_SREP + ((size_t)(pm >> 3) * 64 + g) * 64; oim = a.out + OUT_SIMP + ((size_t)(pm >> 3) * 64 + g) * 64; }
        else { ore = a.out + OUT_SRES; oim = a.out + OUT_SIMS; }
        LAS bf16_t* sin_t = (LAS bf16_t*)scr;
#pragma unroll
        for (int nbp = 0; nbp < 2; ++nbp) {
            const int p = 32 * nbp + r32;
            if (prompt) {
                const float2 l256 = lbt[(2 * 64 + g) * 64 + p];
                float sr = 0.f, si = 0.f;
                for (int j = pm & ~7; j < pm; ++j) { const float* Ej = (const float*)(a.ws + WS_E) + ((size_t)j * 64 + g) * 128; const float er = Ej[p], ei = Ej[64 + p];
                    const float nr = l256.x * sr - l256.y * si + er, ni = l256.x * si + l256.y * sr + ei; sr = nr; si = ni; }
                float er = sr, ei = si;
#pragma unroll
                for (int i = 0; i < 16; ++i) { const float nr = l8[nbp].x * er - l8[nbp].y * ei + sl[nbp][i], ni = l8[nbp].x * ei + l8[nbp].y * er + sl[nbp + 2][i]; er = nr; ei = ni; }
                const float ur = __shfl_xor(er, 32), ui_ = __shfl_xor(ei, 32);
                if (hh == 1) { sr = ur; si = ui_; }
#pragma unroll
                for (int i = 0; i < 16; ++i) { const float tr = sl[nbp][i], ti = sl[nbp + 2][i]; sl[nbp][i] = sr; sl[nbp + 2][i] = si;
                    const float nr = l8[nbp].x * sr - l8[nbp].y * si + tr, ni = l8[nbp].x * si + l8[nbp].y * sr + ti; sr = nr; si = ni; }
                if ((pm & 7) == 7 && hh == 1) { ore[p] = sr; oim[p] = si; }
            } else {
#pragma unroll
                for (int i = 0; i < 16; ++i) { const size_t bq = (size_t)((pm - 64) * 32 + 16 * hh + i);
                    const float sr = a.in[3][(bq * 64 + g) * 64 + p], si = a.in[4][(bq * 64 + g) * 64 + p];
                    const float tr = sl[nbp][i], ti = sl[nbp + 2][i]; sl[nbp][i] = sr; sl[nbp + 2][i] = si;
                    ore[(bq * 64 + g) * 64 + p] = l8[nbp].x * sr - l8[nbp].y * si + tr; oim[(bq * 64 + g) * 64 + p] = l8[nbp].x * si + l8[nbp].y * sr + ti; }
            }
        }
#pragma unroll
        for (int nb = 0; nb < 4; ++nb)
#pragma unroll
            for (int i = 0; i < 16; ++i) { const int row = (i & 3) + 8 * (i >> 2) + 4 * hh; sin_t[row * 136 + 32 * nb + r32] = (bf16_t)f2bf(sl[nb][i]); }
        LDS_WAIT(); asm volatile("" ::: "memory");
        bf16x8 as[8];
#pragma unroll
        for (int ks = 0; ks < 8; ++ks) as[ks] = *(const LAS bf16x8*)(sin_t + r32 * 136 + 16 * ks + 8 * hh);
        LDS_WAIT(); asm volatile("" ::: "memory");
        const bf16_t* Tm = (const bf16_t*)(a.ws + WS_SSMM) + (size_t)g * 16384;
        const bf16_t* Cp = (const bf16_t*)(a.ws + WS_SSMM + 4 * MiB) + (size_t)g * 16384;
        const float* dvec = a.in[20];
        bf16_t* Z = (bf16_t*)(a.ws + WS_ACT);
        const int hc = r32 & 15;
        const float dsc = dvec[g * 16 + hc], gmc = gm[g * 16 + hc];
#pragma unroll 1
        for (int nb = 0; nb < 4; ++nb) { f32x16 y = zero16();
#pragma unroll
            for (int ks = 0; ks < 8; ++ks) { const bf16x8 bfr = *(const bf16x8*)(Tm + (size_t)(32 * nb + r32) * 128 + 16 * ks + 8 * hh);
                y = __builtin_amdgcn_mfma_f32_32x32x16_bf16(au[ks], bfr, y, 0, 0, 0); }
#pragma unroll
            for (int ks = 0; ks < 8; ++ks) { const bf16x8 bfr = *(const bf16x8*)(Cp + (size_t)(32 * nb + r32) * 128 + 16 * ks + 8 * hh);
                y = __builtin_amdgcn_mfma_f32_32x32x16_bf16(as[ks], bfr, y, 0, 0, 0); }
            const int s = 2 * nb + (r32 >> 4);
#pragma unroll
            for (int i = 0; i < 16; ++i) { const int rl = 8 * (16 * hh + i) + s; const size_t row = (size_t)(pm * 256 + rl);
                const float u = X[row * D + g * 16 + hc] * rs[rl] * gmc;
                const float v = y[i] + dsc * u;
                const float z = v * sigmoidf_(1.5957691216057308f * (v + 0.044715f * v * v * v));
                Z[row * LDACT + g * 16 + hc] = (bf16_t)f2bf(z); }
        }
    }
}

template <bool S2>
__device__ __forceinline__ void ssm_phase(Frame& F) {
    const Args& a = *F.a;
    LAS float* rs = (LAS float*)(F.lds + RS_OFF);
    const float* rowss = (const float*)(a.ws + WS_ROWSS) + 2 * ROWSS_STRIDE;
    const int nUnits = (S2 ? NT : 64) * 4;
    for (int L = F.vcu; L < nUnits; L += F.G) {
        const int pm = L >> 2, jb = L & 3;
        __syncthreads();
        if (F.tid < 256) { const f32x4* p = (const f32x4*)(rowss + (size_t)(pm * 256 + F.tid) * 32); float s = 0.f;
#pragma unroll
            for (int j = 0; j < 4; ++j) { const f32x4 v = p[j]; s += (v[0] + v[1]) + (v[2] + v[3]); }
            rs[F.tid] = 1.0f / sqrtf(s * (1.0f / D) + EPS); }
        __syncthreads();
#pragma unroll 1
        for (int k = 0; k < 2; ++k) ssm_item<S2>(F, pm, 16 * jb + 2 * F.wave + k, rs, F.lds + RING_OFF + F.wave * 16384);
    }
}

__device__ __forceinline__ void final_norm(Frame& F) {
    const Args& a = *F.a;
    const float* rowss = (const float*)(a.ws + WS_ROWSS) + 5 * ROWSS_STRIDE;
    const float* gf = a.in[10];
    const int gw = F.vcu * NWAVES + F.wave, NGW = F.G * NWAVES;
    f32x4 gq[4];
#pragma unroll
    for (int j = 0; j < 4; ++j) gq[j] = *(const f32x4*)(gf + 4 * F.lane + 256 * j);
    for (int m = gw; m < M; m += NGW) {
        const float pv = (F.lane < 16) ? rowss[(size_t)m * 32 + F.lane] : 0.f;
        const float r = 1.0f / sqrtf(wave_sum(pv) * (1.0f / D) + EPS);
        float* xr = a.out + OUT_Y + (size_t)m * D;
#pragma unroll
        for (int j = 0; j < 4; ++j) { f32x4 v = *(const f32x4*)(xr + 4 * F.lane + 256 * j); v = v * r * gq[j]; *(f32x4*)(xr + 4 * F.lane + 256 * j) = v; }
    }
}

constexpr int N_PHASES = 14;
__global__ void __launch_bounds__(NWAVES * 64, 2) fwd_megakernel(Args args) {
    extern __shared__ __attribute__((aligned(16))) unsigned char lds_raw[];
    Frame F;
    F.lds = (LAS unsigned char*)lds_raw;
#define REFRAME() do { F.tid = opaque_tid(); F.lane = F.tid & 63; F.wave = __builtin_amdgcn_readfirstlane(F.tid >> 6); } while (0)
    REFRAME();
    F.G = gridDim.x; { const int bx = blockIdx.x; F.vcu = (F.G % 8 == 0) ? (bx % 8) * (F.G / 8) + bx / 8 : bx; }
    F.a = &args;
    volatile LAS unsigned* MISC = (volatile LAS unsigned*)(F.lds + MISC_OFF);
    for (int u = F.tid; u < (LDS_BYTES - MISC_OFF) / 4; u += NWAVES * 64) MISC[u] = 0u;
    __syncthreads();
    unsigned* ctl = (unsigned*)(args.ws + WS_CTL);
    XcdBarrier bar; bar.bar = ctl + CW_BAR; bar.x = 0; bar.st = nullptr;
    if (!MK_PER_PHASE) bar = xcd_barrier_post(ctl + CW_BAR, MISC + 8);
    const int lo = args.ph_lo, hi = args.ph_hi;
#if defined(PHASE_MASK)
#define IN(k) ((((PHASE_MASK) >> (k)) & 1) && lo <= (k) && (k) < hi)
#else
#define IN(k) (lo <= (k) && (k) < hi)
#endif
#define SEAM(k) do { if (!MK_PER_PHASE && lo <= (k) && (k) + 1 < hi) xcd_barrier(bar); } while (0)
    unsigned char* ws = args.ws;
    float* X = args.out + OUT_Y;
    bf16_t* XB = (bf16_t*)(ws + WS_XB);
    bf16_t* ACT = (bf16_t*)(ws + WS_ACT);
    float* rowss = (float*)(ws + WS_ROWSS);
    LAS float* rs = (LAS float*)(F.lds + RS_OFF);
    LAS unsigned char* ring = F.lds + RING_OFF;

    if (IN(0)) { REFRAME(); p0_prologue(F); } SEAM(0);
    if (IN(1)) {
        pg8::Prob S{(const char*)ACT, (const char*)(ws + WS_POOLW), LDACT, 256, 256, 4, NT * 4, 256, nullptr, 0, rs, F.vcu, F.G};
        pg8::EpiPool E{args.in[0], args.in[1], X, XB, args.in[12], rowss + 0 * ROWSS_STRIDE};
        pg8::gemm_phase(ring, S, E);
    } SEAM(1);
#define FFN_PLE_PHASES(layer, pb) \
    if (IN(pb)) {     \
        pg8::Prob S{(const char*)XB, (const char*)(ws + WS_WGU) + (size_t)(layer) * 2 * FF * D * 2, D, D, D, 22, NT * 22, 0, rowss + ((layer) == 0 ? 0 : 3) * ROWSS_STRIDE, (layer) == 0 ? 16 : 32, rs, F.vcu, F.G}; \
        pg8::EpiGateUp E{ACT, rs}; \
        pg8::gemm_phase(ring, S, E); \
    } SEAM(pb); \
    if (IN(pb + 1)) {     \
        pg8::Prob S{(const char*)ACT, (const char*)(ws + WS_WD) + (size_t)(layer) * D * FF * 2, LDACT, FF, FF, 4, NT * 4, 0, nullptr, 0, rs, F.vcu, F.G}; \
        pg8::EpiDown E{X, XB, rowss + ((layer) == 0 ? 1 : 4) * ROWSS_STRIDE}; \
        pg8::gemm_phase(ring, S, E); \
    } SEAM(pb + 1); \
    if (IN(pb + 2)) {     \
        pg8::Prob S{(const char*)(ws + WS_PB) + (size_t)(layer) * M * PLE * 2, (const char*)(ws + WS_WPI) + (size_t)(layer) * D * PLE * 2, PLE, PLE, PLE, 4, NT * 4, 0, nullptr, 0, rs, F.vcu, F.G}; \
        pg8::EpiT E{ACT}; \
        pg8::gemm_phase(ring, S, E); \
    } SEAM(pb + 2); \
    if (IN(pb + 3)) {     \
        pg8::Prob S{(const char*)XB, (const char*)(ws + WS_WPG) + (size_t)(layer) * D * D * 2, D, D, D, 4, NT * 4, 0, rowss + ((layer) == 0 ? 1 : 4) * ROWSS_STRIDE, 16, rs, F.vcu, F.G}; \
        pg8::EpiPle E{X, ACT, rowss + ((layer) == 0 ? 2 : 5) * ROWSS_STRIDE, rs}; \
        pg8::gemm_phase(ring, S, E); \
    } SEAM(pb + 3);
    FFN_PLE_PHASES(0, 2)
    if (IN(6)) { REFRAME(); ssm_phase<false>(F); } SEAM(6);
    if (IN(7)) { REFRAME(); ssm_phase<true>(F); } SEAM(7);
    if (IN(8)) {
        pg8::Prob S{(const char*)ACT, (const char*)(ws + WS_WGLU), LDACT, D, D, 8, NT * 8, 0, nullptr, 0, rs, F.vcu, F.G};
        pg8::EpiGlu E{X, XB, rowss + 3 * ROWSS_STRIDE};
        pg8::gemm_phase(ring, S, E);
    } SEAM(8);
    FFN_PLE_PHASES(1, 9)
    if (IN(13)) { REFRAME(); final_norm(F); }
#undef IN
#undef SEAM
}

extern "C" void kernel_launch(void* const* d_in, const int* in_sizes, int n_in, void* d_out, int out_size, void* d_ws, size_t ws_size, hipStream_t stream) {
    static int grid = 0;
    if (grid == 0) {
        if (n_in != 27 || out_size != (int)OUT_TOTAL || ws_size < WS_END) { fprintf(stderr, "kernel_launch: unexpected shapes (n_in %d out %d ws %zu)\n", n_in, out_size, ws_size); grid = -1; return; }
        int dev = 0, cus = 0;
        if (hipGetDevice(&dev) != hipSuccess || hipDeviceGetAttribute(&cus, hipDeviceAttributeMultiprocessorCount, dev) != hipSuccess) { grid = -1; return; }
        if (hipFuncSetAttribute((const void*)fwd_megakernel, hipFuncAttributeMaxDynamicSharedMemorySize, LDS_BYTES) != hipSuccess) { fprintf(stderr, "kernel_launch: hipFuncSetAttribute failed\n"); grid = -1; return; }
        int per_cu = 0;
        if (hipOccupancyMaxActiveBlocksPerMultiprocessor(&per_cu, (const void*)fwd_megakernel, NWAVES * 64, LDS_BYTES) != hipSuccess || per_cu < 1) fprintf(stderr, "kernel_launch: occupancy query says %d\n", per_cu);
        (void)hipGetLastError();
        grid = cus;
    }
    if (grid < 0) return;
    (void)hipMemsetAsync((char*)d_ws + WS_CTL, 0, CTL_ZERO_BYTES, stream);
    Args a{};
    for (int i = 0; i < 27; ++i) a.in[i] = (const float*)d_in[i];
    a.out = (float*)d_out; a.ws = (unsigned char*)d_ws;
#if MK_PER_PHASE
    for (int p = 0; p < N_PHASES; ++p) { a.ph_lo = p; a.ph_hi = p + 1; a.li = p; hipLaunchKernelGGL(fwd_megakernel, dim3(grid), dim3(NWAVES * 64), LDS_BYTES, stream, a); }
#else
    a.ph_lo = 0; a.ph_hi = N_PHASES; a.li = 0;
    hipLaunchKernelGGL(fwd_megakernel, dim3(grid), dim3(NWAVES * 64), LDS_BYTES, stream, a);
#endif
}
```

```cpp
#include <hip/hip_runtime.h>
#include <cstdio>
#include <cstdint>

#ifndef MK_PER_PHASE
#define MK_PER_PHASE 0
#endif

#define LAS __attribute__((address_space(3)))
#define GAS __attribute__((address_space(1)))
typedef unsigned short bf16_t;
typedef short bf16x8 __attribute__((ext_vector_type(8)));
typedef float f32x4 __attribute__((ext_vector_type(4)));
typedef float f32x16 __attribute__((ext_vector_type(16)));
typedef unsigned u32x4 __attribute__((ext_vector_type(4)));
typedef unsigned u32x2 __attribute__((ext_vector_type(2)));
typedef float f32x2 __attribute__((ext_vector_type(2)));

constexpr int D = 1024, FF = 2816, PLE = 256;
constexpr int NPROMPT = 8 * 2048, NSAMPLE = 128 * 8, M = NPROMPT + NSAMPLE;
constexpr int NT = M / 256;
constexpr float EPS = 1e-6f;
constexpr int LDACT = FF;

constexpr size_t MiB = 1u << 20;
constexpr size_t WS_CTL = 0, CTL_ZERO_BYTES = 1 * MiB;
constexpr size_t WS_POOLW = 1 * MiB;
constexpr size_t WS_WGU = 2 * MiB;
constexpr size_t WS_WD = 24 * MiB;
constexpr size_t WS_WPG = 35 * MiB;
constexpr size_t WS_WPI = 39 * MiB;
constexpr size_t WS_WGLU = 40 * MiB;
constexpr size_t WS_SSMM = 44 * MiB;
constexpr size_t WS_LB = 50 * MiB;
constexpr size_t WS_E = 51 * MiB;
constexpr size_t WS_ROWSS = 54 * MiB;
constexpr size_t WS_PB = 67 * MiB;
constexpr size_t WS_XB = 84 * MiB;
constexpr size_t WS_ACT = 118 * MiB;
constexpr size_t WS_END = 212 * MiB;
static_assert(WS_ACT + (size_t)M * FF * 2 <= WS_END, "ws map");
static_assert(WS_XB + (size_t)M * D * 2 <= WS_ACT, "ws map");
static_assert(WS_PB + (size_t)2 * M * PLE * 2 <= WS_XB, "ws map");
static_assert(WS_ROWSS + (size_t)6 * M * 32 * 4 <= WS_PB, "ws map");
static_assert(WS_E + (size_t)NT * 64 * 128 * 4 <= WS_ROWSS, "ws map");
constexpr size_t ROWSS_STRIDE = (size_t)M * 32;
constexpr int CW_BAR = 4096;

constexpr size_t OUT_Y = 0;
constexpr size_t OUT_POOLP = (size_t)M * D;
constexpr size_t OUT_POOLS = OUT_POOLP + (size_t)8 * 15 * D;
constexpr size_t OUT_SREP = OUT_POOLS + (size_t)128 * 15 * D;
constexpr size_t OUT_SIMP = OUT_SREP + (size_t)8 * 64 * 64;
constexpr size_t OUT_SRES = OUT_SIMP + (size_t)8 * 64 * 64;
constexpr size_t OUT_SIMS = OUT_SRES + (size_t)128 * 64 * 64;
constexpr size_t OUT_TOTAL = OUT_SIMS + (size_t)128 * 64 * 64;

constexpr int RING_OFF = 0, RING_BYTES = 131072;
constexpr int RS_OFF = RING_BYTES;
constexpr int ETAB_OFF = RS_OFF + 8192;
constexpr int MISC_OFF = ETAB_OFF + 4096;
constexpr int LDS_BYTES = 147456;
constexpr int NWAVES = 8;

#define RLX_AGENT __ATOMIC_RELAXED, __HIP_MEMORY_SCOPE_AGENT
#define LDS_WAIT() asm volatile("s_waitcnt lgkmcnt(0)" ::: "memory")
#define VM_WAIT() asm volatile("s_waitcnt vmcnt(0)" ::: "memory")
__device__ __forceinline__ unsigned f2bf(float f) { unsigned u = __builtin_bit_cast(unsigned, f); return (u + 0x7fffu + ((u >> 16) & 1u)) >> 16; }
__device__ __forceinline__ unsigned pk2(float lo, float hi) { return f2bf(lo) | (f2bf(hi) << 16); }
__device__ __forceinline__ unsigned cvt_pk_bf16(float lo, float hi) { unsigned r; asm volatile("v_cvt_pk_bf16_f32 %0, %1, %2" : "=v"(r) : "v"(lo), "v"(hi)); return r; }
__device__ __forceinline__ float bf_lo(unsigned w) { return __builtin_bit_cast(float, w << 16); }
__device__ __forceinline__ float bf_hi(unsigned w) { return __builtin_bit_cast(float, w & 0xffff0000u); }
__device__ __forceinline__ float wave_sum(float v) {
#pragma unroll
    for (int o = 1; o < 64; o <<= 1) v += __shfl_xor(v, o);
    return v;
}
__device__ __forceinline__ float dpp_f(float v, const int ctrl_unused) { return v; }
#define DPP_ADD(v, ctrl) ((v) + __builtin_bit_cast(float, __builtin_amdgcn_update_dpp(0, __builtin_bit_cast(int, (v)), (ctrl), 0xF, 0xF, true)))
__device__ __forceinline__ float wave_sum_u(float v) {
    v = DPP_ADD(v, 0xB1); v = DPP_ADD(v, 0x4E); v = DPP_ADD(v, 0x141); v = DPP_ADD(v, 0x140);
    const int b = __builtin_bit_cast(int, v);
    const float r0 = __builtin_bit_cast(float, __builtin_amdgcn_readlane(b, 15)), r1 = __builtin_bit_cast(float, __builtin_amdgcn_readlane(b, 31));
    const float r2 = __builtin_bit_cast(float, __builtin_amdgcn_readlane(b, 47)), r3 = __builtin_bit_cast(float, __builtin_amdgcn_readlane(b, 63));
    return (r0 + r1) + (r2 + r3);
}
__device__ __forceinline__ int opaque_tid() { int t = threadIdx.x; asm volatile("" : "+v"(t)); return t; }
__device__ __forceinline__ float sigmoidf_(float x) { return 1.0f / (1.0f + __expf(-x)); }
__device__ __forceinline__ float sq4(f32x4 v) { return (v[0] * v[0] + v[1] * v[1]) + (v[2] * v[2] + v[3] * v[3]); }

namespace pg8 {
constexpr int BM = 256, BK = 64, HALF = 128, HTB = HALF * BK * 2  ;
__host__ __device__ __forceinline__ int lds_byte(int r, int c) { const int st = (r >> 4) * 2 + (c >> 5), rr = r & 15, cc = c & 31, ob = rr * 64 + cc * 2; return st * 1024 + (ob ^ (((ob >> 9) & 1) << 5)); }
__host__ __device__ __forceinline__ void stage_rc(int b, int& R, int& C) { const int st = b / 1024, sb = b % 1024, swz = sb ^ (((sb >> 9) & 1) << 5); R = (st >> 1) * 16 + swz / 64; C = (st & 1) * 32 + (swz % 64) / 2; }
__host__ __device__ __forceinline__ int perm32(int rho) { const int n = rho >> 4, i = rho & 15; return 8 * (i >> 2) + 4 * n + (i & 3); }

struct Unit { int pm, pn; };

struct Prob {
    const char* A; const char* Bt;
    int lda, ldb, K;
    int nN, nUnits;
    int acol;
    const float* rowss; int nparts;
    LAS float* rs;
    int c, G;
    __device__ __forceinline__ bool next(int i, Unit& u) const { const int L = i * G + c; if (L >= nUnits) return false; u.pm = L / nN; u.pn = L - u.pm * nN; return true; }
    __device__ __forceinline__ const char* a_base(const Unit& u) const { return A + ((size_t)u.pm * BM * lda + (size_t)u.pn * acol) * 2; }
    __device__ __forceinline__ const char* b_base(const Unit& u) const { return Bt + (size_t)u.pn * BM * ldb * 2; }
    __device__ __forceinline__ void a_ready(const Unit& u, int ui, int tid) const {
        if (rowss != nullptr && tid < 256) {
            const f32x4* p = (const f32x4*)(rowss + (size_t)(u.pm * BM + tid) * 32);
            float s = 0.f;
            for (int j = 0; j < nparts / 4; ++j) { const f32x4 v = p[j]; s += (v[0] + v[1]) + (v[2] + v[3]); }
            rs[(ui & 1) * 256 + tid] = __builtin_amdgcn_rsqf(s * (1.0f / D) + EPS);
        }
    }
};

template <class Epi>
__device__ __forceinline__ void gemm_phase(LAS unsigned char* lds, const Prob& S, const Epi& E) {
    const int tid = opaque_tid(), wid = __builtin_amdgcn_readfirstlane(tid >> 6), lane = tid & 63, wr = wid >> 2, wc = wid & 3, fr = lane & 15, fq = lane >> 4;
    const int K = S.K, nt = K / BK;
    unsigned voffA[2], voffB[2];
#pragma unroll
    for (int i = 0; i < 2; ++i) { int R, C; stage_rc(tid * 16 + i * 8192, R, C); const int Rb = (R & ~31) + perm32(R & 31);
        voffA[i] = (unsigned)(R * S.lda + C) * 2u; voffB[i] = (unsigned)(Rb * S.ldb + C) * 2u; }
    const size_t kstep = (size_t)(BK * 2);
    const size_t hstepA = (size_t)HALF * S.lda * 2, hstepB = (size_t)HALF * S.ldb * 2;
    const unsigned ldsw = (unsigned)wid * 1024u;
    const int aoff = lds_byte(wr * 64 + fr, fq * 8), boff = lds_byte(wc * 32 + fr, fq * 8);
#define PG8_SA(b, h) (((b) * 2 + (h)) * HTB)
#define PG8_SB(b, h) ((4 + (b) * 2 + (h)) * HTB)
#define PG8_STAGE(bufoff, gbase, voff) do { _Pragma("unroll") for (int _i = 0; _i < 2; ++_i) \
        __builtin_amdgcn_global_load_lds((const unsigned*)((const char*)(gbase) + (voff)[_i]), (LAS unsigned*)(lds + (bufoff) + ldsw + _i * 8192), 16, 0, 0); } while (0)
#define PG8_LDA(dst, b, h) do { _Pragma("unroll") for (int m = 0; m < 4; ++m) _Pragma("unroll") for (int k = 0; k < 2; ++k) dst[m][k] = *(const LAS bf16x8*)(lds + PG8_SA(b, h) + aoff + m * 2048 + k * 1024); } while (0)
#define PG8_LDB(dst, b, h) do { _Pragma("unroll") for (int n = 0; n < 2; ++n) _Pragma("unroll") for (int k = 0; k < 2; ++k) dst[n][k] = *(const LAS bf16x8*)(lds + PG8_SB(b, h) + boff + n * 2048 + k * 1024); } while (0)
#define PG8_MMA(ai, bj, At, Bt) do { __builtin_amdgcn_s_setprio(1); _Pragma("unroll") for (int m = 0; m < 4; ++m) _Pragma("unroll") for (int n = 0; n < 2; ++n) _Pragma("unroll") for (int k = 0; k < 2; ++k) \
        acc[ai][bj][m][n] = __builtin_amdgcn_mfma_f32_16x16x32_bf16(Bt[n][k], At[m][k], acc[ai][bj][m][n], 0, 0, 0); __builtin_amdgcn_s_setprio(0); } while (0)
#define PG8_WAIT_V(n) asm volatile("s_waitcnt vmcnt(" #n ")" ::: "memory")
#define PG8_WAIT_L(n) asm volatile("s_waitcnt lgkmcnt(" #n ")" ::: "memory")
#define PG8_BAR __builtin_amdgcn_s_barrier()
#define PG8_SCHED __builtin_amdgcn_sched_barrier(0)
    Unit cur, nxt; int ui = 0;
    if (!S.next(0, cur)) return;
    f32x4 acc[2][2][4][2];
#pragma unroll
    for (int a = 0; a < 2; ++a)
#pragma unroll
        for (int b = 0; b < 2; ++b)
#pragma unroll
            for (int m = 0; m < 4; ++m)
#pragma unroll
                for (int n = 0; n < 2; ++n) acc[a][b][m][n] = (f32x4){0.f, 0.f, 0.f, 0.f};
    bf16x8 At[4][2], B0[2][2], B1[2][2];
    const char* cA = S.a_base(cur); const char* cB = S.b_base(cur);
    S.a_ready(cur, 0, tid);
    PG8_STAGE(PG8_SB(0, 0), cB, voffB); PG8_STAGE(PG8_SB(0, 1), cB + hstepB, voffB); PG8_STAGE(PG8_SA(0, 0), cA, voffA); PG8_STAGE(PG8_SA(0, 1), cA + hstepA, voffA);
    if (wr == 1) PG8_BAR;
    PG8_WAIT_V(2); PG8_BAR;
    PG8_STAGE(PG8_SB(1, 0), cB + kstep, voffB); PG8_STAGE(PG8_SA(1, 0), cA + kstep, voffA); PG8_STAGE(PG8_SB(1, 1), cB + hstepB + kstep, voffB);
    PG8_WAIT_V(6); PG8_BAR;
    for (;;) {
        const bool has_next = S.next(ui + 1, nxt);
        const char* nA = has_next ? S.a_base(nxt) : cA; const char* nB = has_next ? S.b_base(nxt) : cB;
        for (int t = 0; t < nt; t += 2) {
            const bool last = (t == nt - 2);
            const char* a1 = cA + (size_t)(t + 1) * kstep;
            const char* a2 = last ? nA : cA + (size_t)(t + 2) * kstep; const char* b2 = last ? nB : cB + (size_t)(t + 2) * kstep;
            const char* a3 = a2 + kstep; const char* b3 = b2 + kstep;
            if (last && has_next) S.a_ready(nxt, ui + 1, tid);
            PG8_LDB(B0, 0, 0); PG8_LDB(B1, 0, 1); PG8_SCHED; PG8_LDA(At, 0, 0); PG8_STAGE(PG8_SA(1, 1), a1 + hstepA, voffA);
            PG8_WAIT_V(8); PG8_WAIT_L(0); PG8_BAR; PG8_MMA(0, 0, At, B0); PG8_MMA(0, 1, At, B1); PG8_BAR; PG8_SCHED;
            PG8_LDA(At, 0, 1); PG8_STAGE(PG8_SB(0, 0), b2, voffB); PG8_STAGE(PG8_SB(0, 1), b2 + hstepB, voffB); PG8_STAGE(PG8_SA(0, 0), a2, voffA);
            PG8_WAIT_V(8); PG8_WAIT_L(0); PG8_BAR; PG8_MMA(1, 0, At, B0); PG8_MMA(1, 1, At, B1); PG8_BAR; PG8_SCHED;
            PG8_LDB(B0, 1, 0); PG8_LDB(B1, 1, 1); PG8_SCHED; PG8_LDA(At, 1, 0); PG8_STAGE(PG8_SA(0, 1), a2 + hstepA, voffA);
            PG8_WAIT_V(8); PG8_WAIT_L(0); PG8_BAR; PG8_MMA(0, 0, At, B0); PG8_MMA(0, 1, At, B1); PG8_BAR; PG8_SCHED;
            PG8_LDA(At, 1, 1); PG8_STAGE(PG8_SB(1, 0), b3, voffB); PG8_STAGE(PG8_SB(1, 1), b3 + hstepB, voffB); PG8_STAGE(PG8_SA(1, 0), a3, voffA);
            PG8_WAIT_V(8); PG8_WAIT_L(0); PG8_BAR; PG8_MMA(1, 0, At, B0); PG8_MMA(1, 1, At, B1); PG8_BAR; PG8_SCHED;
        }
        if (wr == 0) PG8_BAR;
        E(acc, cur, ui, wr, wc, fr, fq);
        if (!has_next) break;
#pragma unroll
        for (int a = 0; a < 2; ++a)
#pragma unroll
            for (int b = 0; b < 2; ++b)
#pragma unroll
                for (int m = 0; m < 4; ++m)
#pragma unroll
                    for (int n = 0; n < 2; ++n) acc[a][b][m][n] = (f32x4){0.f, 0.f, 0.f, 0.f};
        cur = nxt; cA = nA; cB = nB; ++ui;
        if (wr == 1) PG8_BAR;
    }
    PG8_WAIT_V(0);
    PG8_BAR;
#undef PG8_SA
#undef PG8_SB
#undef PG8_STAGE
#undef PG8_LDA
#undef PG8_LDB
#undef PG8_MMA
#undef PG8_WAIT_V
#undef PG8_WAIT_L
#undef PG8_BAR
#undef PG8_SCHED
}

typedef const f32x4 (&AccRef)[2][2][4][2];

struct EpiPool {
    const float* xp; const float* xs; float* X; bf16_t* XB; const float* scale; float* rowss;
    __device__ __forceinline__ void operator()(AccRef acc, const Unit& u, int ui, int wr, int wc, int fr, int fq) const {
        const int row0 = u.pm * BM + wr * 64 + fr, col0 = u.pn * BM + wc * 32 + 8 * fq;
        const float* xin = (u.pm < 64) ? xp : (xs - (size_t)NPROMPT * D);
        f32x4 sc[2][2];
#pragma unroll
        for (int bj = 0; bj < 2; ++bj)
#pragma unroll
            for (int n = 0; n < 2; ++n) sc[bj][n] = *(const f32x4*)(scale + col0 + bj * HALF + 4 * n);
#pragma unroll
        for (int ai = 0; ai < 2; ++ai)
#pragma unroll
            for (int m = 0; m < 4; ++m) { const size_t row = (size_t)(row0 + ai * HALF + m * 16); float ssq = 0.f;
#pragma unroll
                for (int bj = 0; bj < 2; ++bj) { const size_t off = row * D + col0 + bj * HALF;
                    const f32x4 v0 = *(const f32x4*)(xin + off) + sc[bj][0] * acc[ai][bj][m][0], v1 = *(const f32x4*)(xin + off + 4) + sc[bj][1] * acc[ai][bj][m][1];
                    *(f32x4*)(X + off) = v0; *(f32x4*)(X + off + 4) = v1; ssq += sq4(v0) + sq4(v1);
                    u32x4 w; w.x = cvt_pk_bf16(v0[0], v0[1]); w.y = cvt_pk_bf16(v0[2], v0[3]); w.z = cvt_pk_bf16(v1[0], v1[1]); w.w = cvt_pk_bf16(v1[2], v1[3]);
                    *(u32x4*)(XB + off) = w; }
                ssq += __shfl_xor(ssq, 16); ssq += __shfl_xor(ssq, 32);
                if (fq == 0) rowss[row * 32 + u.pn * 4 + wc] = ssq; }
    }
};
struct EpiGateUp {
    bf16_t* ACT; const LAS float* rs;
    __device__ __forceinline__ void operator()(AccRef acc, const Unit& u, int ui, int wr, int wc, int fr, int fq) const {
        const int row0 = u.pm * BM + wr * 64 + fr, col0 = u.pn * HALF + wc * 32 + 8 * fq;
#pragma unroll
        for (int ai = 0; ai < 2; ++ai)
#pragma unroll
            for (int m = 0; m < 4; ++m) { const float r = rs[(ui & 1) * 256 + ai * HALF + wr * 64 + m * 16 + fr];
                float a[8];
#pragma unroll
                for (int n = 0; n < 2; ++n)
#pragma unroll
                    for (int e = 0; e < 4; ++e) { const float g = r * acc[ai][0][m][n][e], up = r * acc[ai][1][m][n][e]; a[n * 4 + e] = g * sigmoidf_(g) * up; }
                u32x4 w; w.x = cvt_pk_bf16(a[0], a[1]); w.y = cvt_pk_bf16(a[2], a[3]); w.z = cvt_pk_bf16(a[4], a[5]); w.w = cvt_pk_bf16(a[6], a[7]);
                *(u32x4*)(ACT + (size_t)(row0 + ai * HALF + m * 16) * LDACT + col0) = w; }
    }
};
struct EpiDown {
    float* X; bf16_t* XB; float* rowss;
    __device__ __forceinline__ void operator()(AccRef acc, const Unit& u, int ui, int wr, int wc, int fr, int fq) const {
        const int row0 = u.pm * BM + wr * 64 + fr, col0 = u.pn * BM + wc * 32 + 8 * fq;
#pragma unroll
        for (int ai = 0; ai < 2; ++ai)
#pragma unroll
            for (int m = 0; m < 4; ++m) { const size_t row = (size_t)(row0 + ai * HALF + m * 16); float ssq = 0.f;
#pragma unroll
                for (int bj = 0; bj < 2; ++bj) { const size_t off = row * D + col0 + bj * HALF;
                    const f32x4 v0 = *(const f32x4*)(X + off) + acc[ai][bj][m][0], v1 = *(const f32x4*)(X + off + 4) + acc[ai][bj][m][1];
                    *(f32x4*)(X + off) = v0; *(f32x4*)(X + off + 4) = v1; ssq += sq4(v0) + sq4(v1);
                    u32x4 w; w.x = cvt_pk_bf16(v0[0], v0[1]); w.y = cvt_pk_bf16(v0[2], v0[3]); w.z = cvt_pk_bf16(v1[0], v1[1]); w.w = cvt_pk_bf16(v1[2], v1[3]);
                    *(u32x4*)(XB + off) = w; }
                ssq += __shfl_xor(ssq, 16); ssq += __shfl_xor(ssq, 32);
                if (fq == 0) rowss[row * 32 + u.pn * 4 + wc] = ssq; }
    }
};
struct EpiT {
    bf16_t* T;
    __device__ __forceinline__ void operator()(AccRef acc, const Unit& u, int ui, int wr, int wc, int fr, int fq) const {
        const int row0 = u.pm * BM + wr * 64 + fr, col0 = u.pn * BM + wc * 32 + 8 * fq;
#pragma unroll
        for (int ai = 0; ai < 2; ++ai)
#pragma unroll
            for (int m = 0; m < 4; ++m)
#pragma unroll
                for (int bj = 0; bj < 2; ++bj) { const f32x4 v0 = acc[ai][bj][m][0], v1 = acc[ai][bj][m][1];
                    u32x4 w; w.x = cvt_pk_bf16(v0[0], v0[1]); w.y = cvt_pk_bf16(v0[2], v0[3]); w.z = cvt_pk_bf16(v1[0], v1[1]); w.w = cvt_pk_bf16(v1[2], v1[3]);
                    *(u32x4*)(T + (size_t)(row0 + ai * HALF + m * 16) * LDACT + col0 + bj * HALF) = w; }
    }
};
struct EpiPle {
    float* X; const bf16_t* T; float* rowss; const LAS float* rs;
    __device__ __forceinline__ void operator()(AccRef acc, const Unit& u, int ui, int wr, int wc, int fr, int fq) const {
        const int row0 = u.pm * BM + wr * 64 + fr, col0 = u.pn * BM + wc * 32 + 8 * fq;
#pragma unroll
        for (int ai = 0; ai < 2; ++ai)
#pragma unroll
            for (int m = 0; m < 4; ++m) { const size_t row = (size_t)(row0 + ai * HALF + m * 16); float ssq = 0.f;
                const float r = rs[(ui & 1) * 256 + ai * HALF + wr * 64 + m * 16 + fr];
#pragma unroll
                for (int bj = 0; bj < 2; ++bj) { const size_t off = row * D + col0 + bj * HALF;
                    const u32x4 tw = *(const u32x4*)(T + row * LDACT + col0 + bj * HALF);
                    const f32x4 a0 = acc[ai][bj][m][0], a1 = acc[ai][bj][m][1];
                    f32x4 g0, g1;
#pragma unroll
                    for (int e = 0; e < 4; ++e) { g0[e] = sigmoidf_(r * a0[e]); g1[e] = sigmoidf_(r * a1[e]); }
                    const f32x4 t0 = (f32x4){bf_lo(tw.x), bf_hi(tw.x), bf_lo(tw.y), bf_hi(tw.y)}, t1 = (f32x4){bf_lo(tw.z), bf_hi(tw.z), bf_lo(tw.w), bf_hi(tw.w)};
                    const f32x4 v0 = *(const f32x4*)(X + off) + t0 * g0, v1 = *(const f32x4*)(X + off + 4) + t1 * g1;
                    *(f32x4*)(X + off) = v0; *(f32x4*)(X + off + 4) = v1; ssq += sq4(v0) + sq4(v1); }
                ssq += __shfl_xor(ssq, 16); ssq += __shfl_xor(ssq, 32);
                if (fq == 0) rowss[row * 32 + u.pn * 4 + wc] = ssq; }
    }
};
struct EpiGlu {
    float* X; bf16_t* XB; float* rowss;
    __device__ __forceinline__ void operator()(AccRef acc, const Unit& u, int ui, int wr, int wc, int fr, int fq) const {
        const int row0 = u.pm * BM + wr * 64 + fr, col0 = u.pn * HALF + wc * 32 + 8 * fq;
#pragma unroll
        for (int ai = 0; ai < 2; ++ai)
#pragma unroll
            for (int m = 0; m < 4; ++m) { const size_t row = (size_t)(row0 + ai * HALF + m * 16); const size_t off = row * D + col0;
                f32x4 g0, g1;
#pragma unroll
                for (int e = 0; e < 4; ++e) { g0[e] = sigmoidf_(acc[ai][1][m][0][e]); g1[e] = sigmoidf_(acc[ai][1][m][1][e]); }
                const f32x4 v0 = *(const f32x4*)(X + off) + acc[ai][0][m][0] * g0, v1 = *(const f32x4*)(X + off + 4) + acc[ai][0][m][1] * g1;
                *(f32x4*)(X + off) = v0; *(f32x4*)(X + off + 4) = v1; float ssq = sq4(v0) + sq4(v1);
                u32x4 w; w.x = cvt_pk_bf16(v0[0], v0[1]); w.y = cvt_pk_bf16(v0[2], v0[3]); w.z = cvt_pk_bf16(v1[0], v1[1]); w.w = cvt_pk_bf16(v1[2], v1[3]);
                *(u32x4*)(XB + off) = w;
                ssq += __shfl_xor(ssq, 16); ssq += __shfl_xor(ssq, 32);
                if (fq == 0) rowss[row * 32 + u.pn * 4 + wc] = ssq; }
    }
};
}

#define XB_TMO      128
#define XB_XCNT(j)  (256  + 64 * (j))
#define XB_XSUB(j)  (1280 + 64 * (j))
#define XB_XGEN(j)  (2304 + 64 * (j))
#define XB_TOP      3328
#define XB_TOPGEN   3392
#define XCD_BAR_WORDS 3456
#define XB_SPIN_CAP (1u << 18)
__device__ __forceinline__ unsigned xb_ld(unsigned* p)              { return __hip_atomic_load(p, __ATOMIC_RELAXED, __HIP_MEMORY_SCOPE_AGENT); }
__device__ __forceinline__ unsigned xb_add(unsigned* p, unsigned v) { return __hip_atomic_fetch_add(p, v, __ATOMIC_RELAXED, __HIP_MEMORY_SCOPE_AGENT); }
__device__ __forceinline__ unsigned xb_xcc_id() { return (unsigned)__builtin_amdgcn_s_getreg((3 << 11) | 20) & 0xFu; }
#define XB_SPIN(cond, bar) do { unsigned _sp = 0; while (cond) { __builtin_amdgcn_s_sleep(1); \
    if ((++_sp & 255u) == 0u) { if (xb_ld(&(bar)[XB_TMO])) break; if (_sp > XB_SPIN_CAP) { atomicAdd(&(bar)[XB_TMO], 1u); break; } } } } while (0)
struct XcdBarrier { unsigned* bar; unsigned x; volatile LAS unsigned* st; };
__device__ __forceinline__ XcdBarrier xcd_barrier_post(unsigned* bar, volatile LAS unsigned* st) {
    XcdBarrier b; b.bar = bar; b.x = xb_xcc_id(); b.st = st;
    if (threadIdx.x == 0) (void)xb_add(&bar[XB_XCNT(b.x)], 1u);
    return b;
}
__device__ __forceinline__ void xcd_barrier_complete(unsigned* bar, unsigned x, unsigned& nloc, unsigned& nx) {
    const unsigned G = gridDim.x * gridDim.y * gridDim.z;
    unsigned sum, cnt, mine, sp = 0u;
    for (;;) {
        sum = 0u; cnt = 0u; mine = 0u;
#pragma unroll
        for (unsigned j = 0; j < 16; ++j) { const unsigned c = xb_ld(&bar[XB_XCNT(j)]); sum += c; cnt += (c > 0u) ? 1u : 0u; mine = (j == x) ? c : mine; }
        if (sum == G) break;
        __builtin_amdgcn_s_sleep(1);
        if ((++sp & 255u) == 0u) { if (xb_ld(&bar[XB_TMO])) break; if (sp > XB_SPIN_CAP) { atomicAdd(&bar[XB_TMO], 1u); break; } }
    }
    nloc = mine > 0u ? mine : 1u; nx = cnt > 0u ? cnt : 1u;
}
__device__ __forceinline__ void xcd_barrier(const XcdBarrier& b) {
    asm volatile("s_waitcnt vmcnt(0)" ::: "memory");
    __syncthreads();
    if (threadIdx.x == 0) {
        unsigned* bar = b.bar;
        __builtin_amdgcn_s_waitcnt(0);
        unsigned nloc = b.st[0], nx = b.st[1];
        if (nloc == 0u) { xcd_barrier_complete(bar, b.x, nloc, nx); b.st[0] = nloc; b.st[1] = nx; }
        const unsigned old = xb_add(&bar[XB_XSUB(b.x)], 1u);
        const unsigned gen = old / nloc;
        if (old + 1u == (gen + 1u) * nloc) {
            __builtin_amdgcn_fence(__ATOMIC_RELEASE, "agent");
            asm volatile("s_waitcnt vmcnt(0)" ::: "memory");
            const unsigned og = xb_add(&bar[XB_TOP], 1u);
            const unsigned tg = og / nx;
            if (og + 1u == (tg + 1u) * nx) xb_add(&bar[XB_TOPGEN], 1u);
            else XB_SPIN(xb_ld(&bar[XB_TOPGEN]) == tg, bar);
            __builtin_amdgcn_fence(__ATOMIC_ACQUIRE, "agent");
            xb_add(&bar[XB_XGEN(b.x)], 1u);
            asm volatile("s_waitcnt vmcnt(0)" ::: "memory");
        } else {
            XB_SPIN(xb_ld(&bar[XB_XGEN(b.x)]) == gen, bar);
            __builtin_amdgcn_fence(__ATOMIC_ACQUIRE, "agent");
            asm volatile("s_waitcnt vmcnt(0)" ::: "memory");
        }
    }
    __syncthreads();
}

struct Args {
    const float* in[27];
    float* out; unsigned char* ws;
    int ph_lo, ph_hi, li, pad;
};
struct Frame {
    LAS unsigned char* lds; int tid, lane, wave, vcu, G;
    const Args* a;
};

__device__ __forceinline__ void p0_transpose_item(const float* W, int ldw, int coff, int Nsub, int K, bf16_t* WT, const float* gs, int interleave, int half, LAS float* scr, int item, int lane) {
    const int nblk = Nsub / 32, kb = item / nblk, nb = item % nblk, k0 = 64 * kb, n0 = 32 * nb;
#pragma unroll 8
    for (int i = 0; i < 32; ++i) { const int kk = 2 * i + (lane >> 5); float v = W[(size_t)(k0 + kk) * ldw + coff + n0 + (lane & 31)]; if (gs) v *= gs[k0 + kk]; scr[kk * 33 + (lane & 31)] = v; }
    LDS_WAIT(); asm volatile("" ::: "memory");
    const int c = lane & 7;
#pragma unroll
    for (int j = 0; j < 4; ++j) { const int nl = (lane >> 3) + 8 * j, n = n0 + nl; const LAS float* s = scr + (8 * c) * 33 + nl;
        const int orow = interleave ? ((n >> 7) * 256 + half * 128 + (n & 127)) : n;
        u32x4 o; o.x = pk2(s[0 * 33], s[1 * 33]); o.y = pk2(s[2 * 33], s[3 * 33]); o.z = pk2(s[4 * 33], s[5 * 33]); o.w = pk2(s[6 * 33], s[7 * 33]);
        *(u32x4*)(WT + (size_t)orow * K + k0 + 8 * c) = o; }
    LDS_WAIT(); asm volatile("" ::: "memory");
}

__device__ __forceinline__ void sincos_d(double x, double& s, double& c) {
    const double k = __builtin_rint(x * 0.63661977236758134308);
    double r = __builtin_fma(-k, 1.57079632679489655800e+00, x);
    r = __builtin_fma(-k, 6.12323399573676603587e-17, r);
    const double r2 = r * r;
    double sp = -7.6471637318198164759e-13;
    sp = sp * r2 + 1.6059043836821614599e-10; sp = sp * r2 - 2.5052108385441718775e-08; sp = sp * r2 + 2.7557319223985890653e-06;
    sp = sp * r2 - 1.9841269841269841270e-04; sp = sp * r2 + 8.3333333333333333333e-03; sp = sp * r2 - 1.6666666666666666667e-01;
    const double sr = r + r * r2 * sp;
    double cp = 4.7794773323873852974e-14;
    cp = cp * r2 - 1.1470745597729724714e-11; cp = cp * r2 + 2.0876756987868098979e-09; cp = cp * r2 - 2.7557319223985890653e-07;
    cp = cp * r2 + 2.4801587301587301587e-05; cp = cp * r2 - 1.3888888888888888889e-03; cp = cp * r2 + 4.1666666666666666667e-02; cp = cp * r2 - 0.5;
    const double cr = 1.0 + r2 * cp;
    const long long q = (long long)k & 3;
    s = (q == 0) ? sr : (q == 1) ? cr : (q == 2) ? -sr : -cr;
    c = (q == 0) ? cr : (q == 1) ? -sr : (q == 2) ? -cr : sr;
}
__device__ __forceinline__ double exp_d(double x) {
    const double n = __builtin_rint(x * 1.44269504088896340736);
    const double r = __builtin_fma(-n, 6.93147180369123816490e-01, x) - n * 1.90821492927058770002e-10;
    double p = 1.0 / 6227020800.0;
    p = p * r + 1.0 / 479001600.0; p = p * r + 1.0 / 39916800.0; p = p * r + 1.0 / 3628800.0; p = p * r + 1.0 / 362880.0; p = p * r + 1.0 / 40320.0;
    p = p * r + 1.0 / 5040.0; p = p * r + 1.0 / 720.0; p = p * r + 1.0 / 120.0; p = p * r + 1.0 / 24.0; p = p * r + 1.0 / 6.0; p = p * r + 0.5; p = p * r + 1.0; p = p * r + 1.0;
    return __builtin_ldexp(p, (int)n);
}

struct SsmP { double dt, lr, li; };
__device__ __forceinline__ SsmP ssm_p(const Args& a, int g, int p) { SsmP r; r.dt = exp_d((double)a.in[15][g]); r.lr = (double)a.in[13][g * 64 + p]; r.li = (double)a.in[14][g * 64 + p]; return r; }
__device__ __forceinline__ void lb_pow(const SsmP& q, int k, double& re, double& im) { const double mag = exp_d(q.lr * q.dt * k); double sn, cs; sincos_d(q.li * q.dt * k, sn, cs); re = mag * cs; im = mag * sn; }
__device__ __forceinline__ void ssm_bb_to_lds(const Args& a, const SsmP& q, int g, int p, LAS f32x2* Bb) {
    double l1r, l1i; lb_pow(q, 1, l1r, l1i);
    const double den = q.lr * q.lr + q.li * q.li;
    const double fre = ((l1r - 1.0) * q.lr + l1i * q.li) / den, fim = (l1i * q.lr - (l1r - 1.0) * q.li) / den;
    const f32x4* br4 = (const f32x4*)(a.in[16] + (size_t)(g * 64 + p) * 16); const f32x4* bi4 = (const f32x4*)(a.in[17] + (size_t)(g * 64 + p) * 16);
#pragma unroll
    for (int i4 = 0; i4 < 4; ++i4) { const f32x4 br = br4[i4], bi = bi4[i4];
#pragma unroll
        for (int e = 0; e < 4; ++e) Bb[p * 16 + 4 * i4 + e] = (f32x2){(float)(fre * (double)br[e] - fim * (double)bi[e]), (float)(fre * (double)bi[e] + fim * (double)br[e])}; }
}
__device__ __forceinline__ void p0_ssm_kk(const Args& a, int g, int k, LAS float* scr, int lane) {
    bf16_t* Tm = (bf16_t*)(a.ws + WS_SSMM) + (size_t)g * 16384;
    LAS f32x2* Bb = (LAS f32x2*)scr;
    LAS f32x2* lbk = (LAS f32x2*)(scr + 2048);
    const SsmP q = ssm_p(a, g, lane);
    { double re, im; lb_pow(q, k, re, im); lbk[lane] = (f32x2){(float)re, (float)im}; }
    ssm_bb_to_lds(a, q, g, lane, Bb);
    LDS_WAIT(); asm volatile("" ::: "memory");
    const float* c_re = a.in[18]; const float* c_im = a.in[19];
#pragma unroll
    for (int m = 0; m < 4; ++m) { const int idx = lane + 64 * m, h = idx >> 4, i = idx & 15; float acc = 0.f;
        const f32x4* cr4 = (const f32x4*)(c_re + (size_t)(g * 16 + h) * 64); const f32x4* ci4 = (const f32x4*)(c_im + (size_t)(g * 16 + h) * 64);
#pragma unroll 4
        for (int p4 = 0; p4 < 16; ++p4) { const f32x4 cr = cr4[p4], ci = ci4[p4];
#pragma unroll
            for (int e = 0; e < 4; ++e) { const f32x2 l = lbk[4 * p4 + e], b = Bb[(4 * p4 + e) * 16 + i]; const float tr = l.x * b.x - l.y * b.y, ti = l.x * b.y + l.y * b.x; acc += cr[e] * tr - ci[e] * ti; } }
        const bf16_t v = (bf16_t)f2bf(acc);
        for (int sp = 0; sp + k < 8; ++sp) { Tm[(size_t)((sp + k) * 16 + h) * 128 + sp * 16 + i] = v; if (k > 0) Tm[(size_t)(sp * 16 + h) * 128 + (sp + k) * 16 + i] = 0; } }
    LDS_WAIT(); asm volatile("" ::: "memory");
}
__device__ __forceinline__ void p0_ssm_bpow(const Args& a, int g, LAS float* scr, int lane) {
    bf16_t* Bp = (bf16_t*)(a.ws + WS_SSMM + 2 * MiB) + (size_t)g * 16384;
    float2* lbt = (float2*)(a.ws + WS_LB);
    LAS f32x2* Bb = (LAS f32x2*)scr;
    LAS f32x2* lbp = (LAS f32x2*)(scr + 2048);
    const SsmP q = ssm_p(a, g, lane);
    for (int k = 0; k < 8; ++k) { double re, im; lb_pow(q, k, re, im); lbp[k * 64 + lane] = (f32x2){(float)re, (float)im}; }
    { double re, im; lb_pow(q, 8, re, im); lbt[(0 * 64 + g) * 64 + lane] = make_float2((float)re, (float)im);
      lb_pow(q, 128, re, im); lbt[(1 * 64 + g) * 64 + lane] = make_float2((float)re, (float)im);
      lb_pow(q, 256, re, im); lbt[(2 * 64 + g) * 64 + lane] = make_float2((float)re, (float)im); }
    ssm_bb_to_lds(a, q, g, lane, Bb);
    LDS_WAIT(); asm volatile("" ::: "memory");
    const int sp = lane >> 3, i0 = 2 * (lane & 7);
#pragma unroll 4
    for (int pp = 0; pp < 64; ++pp) { const f32x2 l = lbp[(7 - sp) * 64 + pp], b0 = Bb[pp * 16 + i0], b1 = Bb[pp * 16 + i0 + 1];
        const float r0 = l.x * b0.x - l.y * b0.y, m0 = l.x * b0.y + l.y * b0.x, r1 = l.x * b1.x - l.y * b1.y, m1 = l.x * b1.y + l.y * b1.x;
        *(unsigned*)(Bp + (size_t)pp * 128 + 2 * lane) = pk2(r0, r1); *(unsigned*)(Bp + (size_t)(64 + pp) * 128 + 2 * lane) = pk2(m0, m1); }
    LDS_WAIT(); asm volatile("" ::: "memory");
}
__device__ __forceinline__ void p0_ssm_cpow(const Args& a, int g, int lane) {
    bf16_t* Cp = (bf16_t*)(a.ws + WS_SSMM + 4 * MiB) + (size_t)g * 16384;
    const float* c_re = a.in[18]; const float* c_im = a.in[19];
    const SsmP q = ssm_p(a, g, lane);
    for (int s = 0; s < 8; ++s) { double re, im; lb_pow(q, s + 1, re, im); const float lx = (float)re, ly = (float)im;
#pragma unroll 8
        for (int h = 0; h < 16; ++h) { const float cr = c_re[(g * 16 + h) * 64 + lane], ci = c_im[(g * 16 + h) * 64 + lane];
            Cp[(size_t)(s * 16 + h) * 128 + lane] = (bf16_t)f2bf(cr * lx - ci * ly); Cp[(size_t)(s * 16 + h) * 128 + 64 + lane] = (bf16_t)f2bf(-(cr * ly + ci * lx)); } }
}

__device__ __forceinline__ void p0_pool_strip(const Args& a, int s, int lane) {
    const float* gm = a.in[7];
    const bool prompt = s < 2048;
    int t0, b; size_t row0; const float* x; const float* prev = nullptr; float* pout = nullptr;
    if (prompt) { b = s >> 8; t0 = (s & 255) * 8; row0 = (size_t)b * 2048 + t0; x = a.in[0] + row0 * D; if (t0 == 2040) pout = a.out + OUT_POOLP + (size_t)b * 15 * D; }
    else { b = s - 2048; t0 = 0; row0 = (size_t)NPROMPT + (size_t)b * 8; x = a.in[1] + (size_t)b * 8 * D; prev = a.in[2] + (size_t)b * 15 * D; pout = a.out + OUT_POOLS + (size_t)b * 15 * D; }
    bf16_t* diff = (bf16_t*)(a.ws + WS_ACT) + row0 * LDACT;
    float rr[23];
#pragma unroll
    for (int src = -15; src < 8; ++src) {
        rr[src + 15] = 0.f;
        if ((src >= 0) || (prompt && t0 + src >= 0)) {
            const float* xr = x + (ptrdiff_t)src * D; float ss = 0.f;
#pragma unroll
            for (int j = 0; j < 4; ++j) ss += sq4(*(const f32x4*)(xr + 4 * lane + 256 * j));
            rr[src + 15] = 1.0f / sqrtf(wave_sum_u(ss) * (1.0f / D) + EPS);
        }
    }
    f32x4 gq[4];
#pragma unroll
    for (int j = 0; j < 4; ++j) gq[j] = *(const f32x4*)(gm + 4 * lane + 256 * j);
    f32x4 S[4][8];
#pragma unroll
    for (int j = 0; j < 4; ++j)
#pragma unroll
        for (int i = 0; i < 8; ++i) S[j][i] = (f32x4){0.f, 0.f, 0.f, 0.f};
#pragma unroll
    for (int src = -15; src < 8; ++src) {
        f32x4 hv[4];
        bool have = true;
        if (src < 0 && !prompt) {
#pragma unroll
            for (int j = 0; j < 4; ++j) hv[j] = *(const f32x4*)(prev + (size_t)(15 + src) * D + 4 * lane + 256 * j);
        } else if (src < 0 && t0 + src < 0) {
            have = false;
#pragma unroll
            for (int j = 0; j < 4; ++j) hv[j] = (f32x4){0.f, 0.f, 0.f, 0.f};
        } else {
            const float* xr = x + (ptrdiff_t)src * D; const float r = rr[src + 15];
#pragma unroll
            for (int j = 0; j < 4; ++j) hv[j] = *(const f32x4*)(xr + 4 * lane + 256 * j) * r * gq[j];
        }
        if (have) {
#pragma unroll
            for (int j = 0; j < 4; ++j) { const int w = 2 << j;
#pragma unroll
                for (int i = 0; i < 8; ++i) if (i >= src && i <= src + w - 1) S[j][i] += hv[j]; }
        }
        if (src >= 0) {
#pragma unroll
            for (int j = 0; j < 4; ++j) { const int w = 2 << j; const int cnt = prompt ? ((t0 + src + 1) < w ? (t0 + src + 1) : w) : w;
                const f32x4 d = S[j][src] * (1.0f / (float)cnt) - hv[j];
                u32x2 o; o.x = cvt_pk_bf16(d[0], d[1]); o.y = cvt_pk_bf16(d[2], d[3]);
                *(u32x2*)(diff + (size_t)src * LDACT + 4 * lane + 256 * j) = o; }
        }
        if (src >= -7 && pout != nullptr) {
#pragma unroll
            for (int j = 0; j < 4; ++j) *(f32x4*)(pout + (size_t)(src + 7) * D + 4 * lane + 256 * j) = hv[j];
        }
    }
}

__device__ __forceinline__ void p0_prologue(Frame& F) {
    const Args& a = *F.a;
    LAS float* scr = (LAS float*)(F.lds + RING_OFF + F.wave * 16384);
    const int gw = F.vcu * NWAVES + F.wave, NGW = F.G * NWAVES;
    constexpr int I_SSM = 512 + 64 + 64, I_POOL = 2176, I_PCONV = 2 * M / 32;
    constexpr int I_G = 16 * 88, I_DN = 44 * 32, I_PG = 16 * 32, I_PI = 4 * 32, I_GLU = 16 * 32, I_PW = 4 * 8;
    constexpr int I_LAYER = 2 * I_G + I_DN + I_PG + I_PI;
    constexpr int NITEMS = I_SSM + I_POOL + I_PCONV + 2 * I_LAYER + 2 * I_GLU + 4 * I_PW;
    for (int it = gw; it < NITEMS; it += NGW) {
        int r = it;
        if (r < I_SSM) { if (r < 512) p0_ssm_kk(a, r >> 3, r & 7, scr, F.lane); else if (r < 576) p0_ssm_bpow(a, r - 512, scr, F.lane); else p0_ssm_cpow(a, r - 576, F.lane); continue; } r -= I_SSM;
        if (r < I_POOL) { p0_pool_strip(a, r, F.lane); continue; } r -= I_POOL;
        if (r < I_PCONV) {
            const int layer = r / (M / 32), rb = r % (M / 32); const size_t rowb = (size_t)rb * 32;
            bf16_t* pb = (bf16_t*)(a.ws + WS_PB) + (size_t)layer * M * PLE + rowb * PLE;
            const float* src = (rowb < NPROMPT) ? a.in[5] + ((size_t)layer * NPROMPT + rowb) * PLE : a.in[6] + ((size_t)layer * NSAMPLE + (rowb - NPROMPT)) * PLE;
#pragma unroll 4
            for (int j = 0; j < 32; ++j) { const f32x4 v = *(const f32x4*)(src + (size_t)j * PLE + 4 * F.lane); u32x2 o; o.x = pk2(v[0], v[1]); o.y = pk2(v[2], v[3]); *(u32x2*)(pb + (size_t)j * PLE + 4 * F.lane) = o; }
            continue; }
        r -= I_PCONV;
        if (r < 2 * I_LAYER) {
            const int layer = r / I_LAYER; r %= I_LAYER;
            if (r < I_G) { p0_transpose_item(a.in[22] + (size_t)layer * D * FF, FF, 0, FF, D, (bf16_t*)(a.ws + WS_WGU) + (size_t)layer * 2 * FF * D, a.in[8] + layer * D, 1, 0, scr, r, F.lane); continue; } r -= I_G;
            if (r < I_G) { p0_transpose_item(a.in[23] + (size_t)layer * D * FF, FF, 0, FF, D, (bf16_t*)(a.ws + WS_WGU) + (size_t)layer * 2 * FF * D, a.in[8] + layer * D, 1, 1, scr, r, F.lane); continue; } r -= I_G;
            if (r < I_DN) { p0_transpose_item(a.in[24] + (size_t)layer * FF * D, D, 0, D, FF, (bf16_t*)(a.ws + WS_WD) + (size_t)layer * D * FF, nullptr, 0, 0, scr, r, F.lane); continue; } r -= I_DN;
            if (r < I_PG) { p0_transpose_item(a.in[26] + (size_t)layer * D * D, D, 0, D, D, (bf16_t*)(a.ws + WS_WPG) + (size_t)layer * D * D, a.in[9] + layer * D, 0, 0, scr, r, F.lane); continue; } r -= I_PG;
            p0_transpose_item(a.in[25] + (size_t)layer * PLE * D, D, 0, D, PLE, (bf16_t*)(a.ws + WS_WPI) + (size_t)layer * D * PLE, nullptr, 0, 0, scr, r, F.lane); continue;
        }
        r -= 2 * I_LAYER;
        if (r < 2 * I_GLU) { const int half = r / I_GLU; p0_transpose_item(a.in[21], 2 * D, half * D, D, D, (bf16_t*)(a.ws + WS_WGLU), nullptr, 1, half, scr, r % I_GLU, F.lane); continue; }
        r -= 2 * I_GLU;
        { const int gi = r / I_PW; p0_transpose_item(a.in[11] + (size_t)gi * 256 * 256, 256, 0, 256, 256, (bf16_t*)(a.ws + WS_POOLW) + (size_t)gi * 256 * 256, nullptr, 0, 0, scr, r % I_PW, F.lane); }
    }
}

__device__ __forceinline__ f32x16 zero16() { f32x16 z; for (int i = 0; i < 16; ++i) z[i] = 0.f; return z; }

__device__ __forceinline__ float dpp_add(float v, float src_unused) { return v; }
template <bool PROMPT>
__device__ __forceinline__ void ssm_tile(Frame& F, int pm, int g, int wv) {
    const Args& a = *F.a;
    int lane_ = F.lane; asm volatile("" : "+v"(lane_));
    const int lane = lane_, r32 = lane & 31, hh = lane >> 5;
    const float* X = a.out + OUT_Y;
    const float* gm = a.in[7] + D;
    const int ch = (r32 & 3) + 4 * (r32 >> 3) + 16 * ((r32 >> 2) & 1);
    LAS float* rsw = (LAS float*)(F.lds + RS_OFF) + wv * 256;
    LAS float* etab = (LAS float*)(F.lds + ETAB_OFF);
    LAS unsigned char* sscr = F.lds + 98304 + wv * 4096;
    { const float* rowss = (const float*)(a.ws + WS_ROWSS) + 2 * ROWSS_STRIDE + (size_t)pm * 256 * 32;
#pragma unroll
      for (int j = 0; j < 4; ++j) { const f32x4* p = (const f32x4*)(rowss + (size_t)(lane + 64 * j) * 32); const f32x4 v0 = p[0], v1 = p[1], v2 = p[2], v3 = p[3];
          const float ssum = ((v0[0] + v0[1]) + (v0[2] + v0[3])) + ((v1[0] + v1[1]) + (v1[2] + v1[3])) + ((v2[0] + v2[1]) + (v2[2] + v2[3])) + ((v3[0] + v3[1]) + (v3[2] + v3[3]));
          rsw[lane + 64 * j] = 1.0f / sqrtf(ssum * (1.0f / D) + EPS); } }
    LDS_WAIT(); asm volatile("" ::: "memory");
    bf16x8 au[8];
    { const f32x4 g0 = *(const f32x4*)(gm + g * 16 + 8 * hh), g1 = *(const f32x4*)(gm + g * 16 + 8 * hh + 4);
      f32x4 xv[8][2];
#pragma unroll
      for (int ks = 0; ks < 8; ++ks) { const float* xr = X + (size_t)(pm * 256 + 8 * ch + ks) * D + g * 16 + 8 * hh; xv[ks][0] = *(const f32x4*)xr; xv[ks][1] = *(const f32x4*)(xr + 4); }
#pragma unroll
      for (int ks = 0; ks < 8; ++ks) { const float r = rsw[8 * ch + ks]; const f32x4 v0 = xv[ks][0] * g0 * r, v1 = xv[ks][1] * g1 * r;
          u32x4 w; w.x = cvt_pk_bf16(v0[0], v0[1]); w.y = cvt_pk_bf16(v0[2], v0[3]); w.z = cvt_pk_bf16(v1[0], v1[1]); w.w = cvt_pk_bf16(v1[2], v1[3]);
          au[ks] = __builtin_bit_cast(bf16x8, w); } }
    const unsigned bbase = (unsigned)r32 * 256u, kx = (unsigned)((hh ^ (r32 & 15)) << 4);
#define SSM_BFRAG(mat, nb, ks) (*(const LAS bf16x8*)(F.lds + (mat) * 32768 + (nb) * 8192 + bbase + (kx ^ ((unsigned)(ks) << 5))))
    f32x16 sl[4];
#pragma unroll
    for (int nb = 0; nb < 4; ++nb) { sl[nb] = zero16();
#pragma unroll
        for (int ks = 0; ks < 8; ++ks) sl[nb] = __builtin_amdgcn_mfma_f32_32x32x16_bf16(au[ks], SSM_BFRAG(0, nb, ks), sl[nb], 0, 0, 0);
        __builtin_amdgcn_sched_barrier(0); }
    const float2* lbt = (const float2*)(a.ws + WS_LB);
    float2 l8[2];
#pragma unroll
    for (int nbp = 0; nbp < 2; ++nbp) l8[nbp] = lbt[(0 * 64 + g) * 64 + 32 * nbp + r32];
    float str[2], sti[2];
    if constexpr (PROMPT) {
#pragma unroll
        for (int nbp = 0; nbp < 2; ++nbp) { float er = 0.f, ei = 0.f;
#pragma unroll
            for (int i = 0; i < 16; ++i) { const float nr = l8[nbp].x * er - l8[nbp].y * ei + sl[nbp][i], ni = l8[nbp].x * ei + l8[nbp].y * er + sl[nbp + 2][i]; er = nr; ei = ni; }
            const float lr_ = __shfl_xor(er, 32), li_ = __shfl_xor(ei, 32);
            const float2 l128 = lbt[(1 * 64 + g) * 64 + 32 * nbp + r32];
            if (hh == 1) { etab[wv * 128 + 32 * nbp + r32] = l128.x * lr_ - l128.y * li_ + er; etab[wv * 128 + 64 + 32 * nbp + r32] = l128.x * li_ + l128.y * lr_ + ei; } }
        LDS_WAIT(); __syncthreads();
#pragma unroll
        for (int nbp = 0; nbp < 2; ++nbp) { const int p = 32 * nbp + r32; const float2 l256 = lbt[(2 * 64 + g) * 64 + p]; float sr = 0.f, si = 0.f;
            for (int j = 0; j < wv; ++j) { const float er = etab[j * 128 + p], ei = etab[j * 128 + 64 + p]; const float nr = l256.x * sr - l256.y * si + er, ni = l256.x * si + l256.y * sr + ei; sr = nr; si = ni; }
            str[nbp] = sr; sti[nbp] = si; }
    }
    float* ore; float* oim;
    if (PROMPT) { ore = a.out + OUT_SREP + ((size_t)(pm >> 3) * 64 + g) * 64; oim = a.out + OUT_SIMP + ((size_t)(pm >> 3) * 64 + g) * 64; }
    else { ore = a.out + OUT_SRES; oim = a.out + OUT_SIMS; }
#pragma unroll
    for (int nbp = 0; nbp < 2; ++nbp) {
        const int p = 32 * nbp + r32;
        if constexpr (PROMPT) {
            float sr = str[nbp], si = sti[nbp];
            float er = sr, ei = si;
#pragma unroll
            for (int i = 0; i < 16; ++i) { const float nr = l8[nbp].x * er - l8[nbp].y * ei + sl[nbp][i], ni = l8[nbp].x * ei + l8[nbp].y * er + sl[nbp + 2][i]; er = nr; ei = ni; }
            const float ur = __shfl_xor(er, 32), ui_ = __shfl_xor(ei, 32);
            if (hh == 1) { sr = ur; si = ui_; }
#pragma unroll
            for (int i = 0; i < 16; ++i) { const float tr = sl[nbp][i], ti = sl[nbp + 2][i]; sl[nbp][i] = sr; sl[nbp + 2][i] = si;
                const float nr = l8[nbp].x * sr - l8[nbp].y * si + tr, ni = l8[nbp].x * si + l8[nbp].y * sr + ti; sr = nr; si = ni; }
            if ((pm & 7) == 7 && hh == 1) { ore[p] = sr; oim[p] = si; }
        } else {
            float inr[16], ini[16];
#pragma unroll
            for (int i = 0; i < 16; ++i) { const size_t bq = (size_t)((pm - 64) * 32 + 16 * hh + i); inr[i] = a.in[3][(bq * 64 + g) * 64 + p]; ini[i] = a.in[4][(bq * 64 + g) * 64 + p]; }
#pragma unroll
            for (int i = 0; i < 16; ++i) { const size_t bq = (size_t)((pm - 64) * 32 + 16 * hh + i);
                const float sr = inr[i], si = ini[i];
                const float tr = sl[nbp][i], ti = sl[nbp + 2][i]; sl[nbp][i] = sr; sl[nbp + 2][i] = si;
                ore[(bq * 64 + g) * 64 + p] = l8[nbp].x * sr - l8[nbp].y * si + tr; oim[(bq * 64 + g) * 64 + p] = l8[nbp].x * si + l8[nbp].y * sr + ti; }
        }
    }
    bf16x8 as[8];
#pragma unroll
    for (int half = 0; half < 2; ++half) {
#pragma unroll
        for (int nbp = 0; nbp < 2; ++nbp)
#pragma unroll
            for (int i = 0; i < 16; ++i) { const int row = (i & 3) + 8 * (i >> 2) + 4 * hh, q = 32 * nbp + r32;
                *(LAS bf16_t*)(sscr + row * 128 + (((q >> 3) ^ (row & 7)) << 4) + (q & 7) * 2) = (bf16_t)f2bf(sl[2 * half + nbp][i]); }
        LDS_WAIT(); asm volatile("" ::: "memory");
#pragma unroll
        for (int ks = 0; ks < 4; ++ks) as[4 * half + ks] = *(const LAS bf16x8*)(sscr + r32 * 128 + (((2 * ks + hh) ^ (r32 & 7)) << 4));
        LDS_WAIT(); asm volatile("" ::: "memory");
    }
    const float* dvec = a.in[20];
    bf16_t* Z = (bf16_t*)(a.ws + WS_ACT);
    const int hc = r32 & 15;
    const float dsc = dvec[g * 16 + hc], gmc = gm[g * 16 + hc];
#pragma unroll 1
    for (int nb = 0; nb < 4; ++nb) { f32x16 y = zero16();
        const int s = 2 * nb + (r32 >> 4);
        float xu[16];
#pragma unroll
        for (int i = 0; i < 16; ++i) xu[i] = X[(size_t)(pm * 256 + 8 * (16 * hh + i) + s) * D + g * 16 + hc];
#pragma unroll
        for (int ks = 0; ks < 8; ++ks) y = __builtin_amdgcn_mfma_f32_32x32x16_bf16(au[ks], SSM_BFRAG(1, nb, ks), y, 0, 0, 0);
        __builtin_amdgcn_sched_barrier(0);
#pragma unroll
        for (int ks = 0; ks < 8; ++ks) y = __builtin_amdgcn_mfma_f32_32x32x16_bf16(as[ks], SSM_BFRAG(2, nb, ks), y, 0, 0, 0);
        __builtin_amdgcn_sched_barrier(0);
#pragma unroll
        for (int i = 0; i < 16; ++i) { const int rl = 8 * (16 * hh + i) + s; const size_t row = (size_t)(pm * 256 + rl);
            const float u = xu[i] * rsw[rl] * gmc;
            const float v = y[i] + dsc * u;
            const float z = v * sigmoidf_(1.5957691216057308f * (v + 0.044715f * v * v * v));
            Z[row * LDACT + g * 16 + hc] = (bf16_t)f2bf(z); }
    }
#undef SSM_BFRAG
}

__device__ __forceinline__ void ssm_phase(Frame& F) {
    const Args& a = *F.a;
    const int g = F.vcu & 63, q = F.vcu >> 6;
    if (q >= 4) return;
#pragma unroll
    for (int j = 0; j < 12; ++j) { const int cid = F.tid + 512 * j, mat = cid >> 11, rem = cid & 2047, row = rem >> 4, c = rem & 15;
        const bf16_t* src = (const bf16_t*)(a.ws + WS_SSMM + (size_t)(mat == 0 ? 2 : (mat == 1 ? 0 : 4)) * MiB) + (size_t)g * 16384 + row * 128 + c * 8;
        *(LAS u32x4*)(F.lds + mat * 32768 + row * 256 + ((c ^ (row & 15)) << 4)) = *(const u32x4*)src; }
    LDS_WAIT(); __syncthreads();
#pragma unroll 1
    for (int r = 0; r < 2; ++r) { ssm_tile<true>(F, (2 * q + r) * 8 + F.wave, g, F.wave); __syncthreads(); }
    if (F.wave == 0) ssm_tile<false>(F, 64 + q, g, 0);
    __syncthreads();
}

__device__ __forceinline__ void final_norm(Frame& F) {
    const Args& a = *F.a;
    const float* rowss = (const float*)(a.ws + WS_ROWSS) + 5 * ROWSS_STRIDE;
    const float* gf = a.in[10];
    const int gw = F.vcu * NWAVES + F.wave, NGW = F.G * NWAVES;
    f32x4 gq[4];
#pragma unroll
    for (int j = 0; j < 4; ++j) gq[j] = *(const f32x4*)(gf + 4 * F.lane + 256 * j);
    for (int m = gw; m < M; m += NGW) {
        const float pv = (F.lane < 16) ? rowss[(size_t)m * 32 + F.lane] : 0.f;
        const float r = 1.0f / sqrtf(wave_sum(pv) * (1.0f / D) + EPS);
        float* xr = a.out + OUT_Y + (size_t)m * D;
#pragma unroll
        for (int j = 0; j < 4; ++j) { f32x4 v = *(const f32x4*)(xr + 4 * F.lane + 256 * j); v = v * r * gq[j]; *(f32x4*)(xr + 4 * F.lane + 256 * j) = v; }
    }
}

constexpr int N_PHASES = 14;
__global__ void __launch_bounds__(NWAVES * 64, 2) fwd_megakernel(Args args) {
    extern __shared__ __attribute__((aligned(16))) unsigned char lds_raw[];
    Frame F;
    F.lds = (LAS unsigned char*)lds_raw;
#define REFRAME() do { F.tid = opaque_tid(); F.lane = F.tid & 63; F.wave = __builtin_amdgcn_readfirstlane(F.tid >> 6); } while (0)
    REFRAME();
    F.G = gridDim.x; { const int bx = blockIdx.x; F.vcu = (F.G % 8 == 0) ? (bx % 8) * (F.G / 8) + bx / 8 : bx; }
    F.a = &args;
    volatile LAS unsigned* MISC = (volatile LAS unsigned*)(F.lds + MISC_OFF);
    for (int u = F.tid; u < (LDS_BYTES - MISC_OFF) / 4; u += NWAVES * 64) MISC[u] = 0u;
    __syncthreads();
    unsigned* ctl = (unsigned*)(args.ws + WS_CTL);
    XcdBarrier bar; bar.bar = ctl + CW_BAR; bar.x = 0; bar.st = nullptr;
    if (!MK_PER_PHASE) bar = xcd_barrier_post(ctl + CW_BAR, MISC + 8);
    const int lo = args.ph_lo, hi = args.ph_hi;
#if defined(PHASE_MASK)
#define IN(k) ((((PHASE_MASK) >> (k)) & 1) && lo <= (k) && (k) < hi)
#else
#define IN(k) (lo <= (k) && (k) < hi)
#endif
#define SEAM(k) do { if (!MK_PER_PHASE && lo <= (k) && (k) + 1 < hi) xcd_barrier(bar); } while (0)
#ifndef REPEAT_PHASE
#define REPEAT_PHASE -1
#endif
#define DUP(k, ...) __VA_ARGS__ if ((k) == REPEAT_PHASE) { SEAM(k); __VA_ARGS__ }
    unsigned char* ws = args.ws;
    float* X = args.out + OUT_Y;
    bf16_t* XB = (bf16_t*)(ws + WS_XB);
    bf16_t* ACT = (bf16_t*)(ws + WS_ACT);
    float* rowss = (float*)(ws + WS_ROWSS);
    LAS float* rs = (LAS float*)(F.lds + RS_OFF);
    LAS unsigned char* ring = F.lds + RING_OFF;

    DUP(0, if (IN(0)) { REFRAME(); p0_prologue(F); }) SEAM(0);
    if (IN(1)) {
        pg8::Prob S{(const char*)ACT, (const char*)(ws + WS_POOLW), LDACT, 256, 256, 4, NT * 4, 256, nullptr, 0, rs, F.vcu, F.G};
        pg8::EpiPool E{args.in[0], args.in[1], X, XB, args.in[12], rowss + 0 * ROWSS_STRIDE};
        pg8::gemm_phase(ring, S, E);
    } SEAM(1);
#define FFN_PLE_PHASES(layer, pb) \
    DUP(pb, if (IN(pb)) {     \
        pg8::Prob S{(const char*)XB, (const char*)(ws + WS_WGU) + (size_t)(layer) * 2 * FF * D * 2, D, D, D, 22, NT * 22, 0, rowss + ((layer) == 0 ? 0 : 3) * ROWSS_STRIDE, (layer) == 0 ? 16 : 32, rs, F.vcu, F.G}; \
        pg8::EpiGateUp E{ACT, rs}; \
        pg8::gemm_phase(ring, S, E); \
    }) SEAM(pb); \
    if (IN(pb + 1)) {     \
        pg8::Prob S{(const char*)ACT, (const char*)(ws + WS_WD) + (size_t)(layer) * D * FF * 2, LDACT, FF, FF, 4, NT * 4, 0, nullptr, 0, rs, F.vcu, F.G}; \
        pg8::EpiDown E{X, XB, rowss + ((layer) == 0 ? 1 : 4) * ROWSS_STRIDE}; \
        pg8::gemm_phase(ring, S, E); \
    } SEAM(pb + 1); \
    if (IN(pb + 2)) {     \
        pg8::Prob S{(const char*)(ws + WS_PB) + (size_t)(layer) * M * PLE * 2, (const char*)(ws + WS_WPI) + (size_t)(layer) * D * PLE * 2, PLE, PLE, PLE, 4, NT * 4, 0, nullptr, 0, rs, F.vcu, F.G}; \
        pg8::EpiT E{ACT}; \
        pg8::gemm_phase(ring, S, E); \
    } SEAM(pb + 2); \
    if (IN(pb + 3)) {     \
        pg8::Prob S{(const char*)XB, (const char*)(ws + WS_WPG) + (size_t)(layer) * D * D * 2, D, D, D, 4, NT * 4, 0, rowss + ((layer) == 0 ? 1 : 4) * ROWSS_STRIDE, 16, rs, F.vcu, F.G}; \
        pg8::EpiPle E{X, ACT, rowss + ((layer) == 0 ? 2 : 5) * ROWSS_STRIDE, rs}; \
        pg8::gemm_phase(ring, S, E); \
    } SEAM(pb + 3);
    FFN_PLE_PHASES(0, 2)
    DUP(7, if (IN(7)) { REFRAME(); ssm_phase(F); }) SEAM(7);
    if (IN(8)) {
        pg8::Prob S{(const char*)ACT, (const char*)(ws + WS_WGLU), LDACT, D, D, 8, NT * 8, 0, nullptr, 0, rs, F.vcu, F.G};
        pg8::EpiGlu E{X, XB, rowss + 3 * ROWSS_STRIDE};
        pg8::gemm_phase(ring, S, E);
    } SEAM(8);
    FFN_PLE_PHASES(1, 9)
    if (IN(13)) { REFRAME(); final_norm(F); }
#undef IN
#undef SEAM
}

extern "C" void kernel_launch(void* const* d_in, const int* in_sizes, int n_in, void* d_out, int out_size, void* d_ws, size_t ws_size, hipStream_t stream) {
    static int grid = 0;
    if (grid == 0) {
        if (n_in != 27 || out_size != (int)OUT_TOTAL || ws_size < WS_END) { fprintf(stderr, "kernel_launch: unexpected shapes (n_in %d out %d ws %zu)\n", n_in, out_size, ws_size); grid = -1; return; }
        int dev = 0, cus = 0;
        if (hipGetDevice(&dev) != hipSuccess || hipDeviceGetAttribute(&cus, hipDeviceAttributeMultiprocessorCount, dev) != hipSuccess) { grid = -1; return; }
        if (hipFuncSetAttribute((const void*)fwd_megakernel, hipFuncAttributeMaxDynamicSharedMemorySize, LDS_BYTES) != hipSuccess) { fprintf(stderr, "kernel_launch: hipFuncSetAttribute failed\n"); grid = -1; return; }
        int per_cu = 0;
        if (hipOccupancyMaxActiveBlocksPerMultiprocessor(&per_cu, (const void*)fwd_megakernel, NWAVES * 64, LDS_BYTES) != hipSuccess || per_cu < 1) fprintf(stderr, "kernel_launch: occupancy query says %d\n", per_cu);
        (void)hipGetLastError();
        if (cus < 256) { fprintf(stderr, "kernel_launch: needs a 256-CU device (got %d)\n", cus); grid = -1; return; }
        grid = 256;
    }
    if (grid < 0) return;
    (void)hipMemsetAsync((char*)d_ws + WS_CTL, 0, CTL_ZERO_BYTES, stream);
    Args a{};
    for (int i = 0; i < 27; ++i) a.in[i] = (const float*)d_in[i];
    a.out = (float*)d_out; a.ws = (unsigned char*)d_ws;
#if MK_PER_PHASE
    for (int p = 0; p < N_PHASES; ++p) { a.ph_lo = p; a.ph_hi = p + 1; a.li = p; hipLaunchKernelGGL(fwd_megakernel, dim3(grid), dim3(NWAVES * 64), LDS_BYTES, stream, a); }
#else
    a.ph_lo = 0; a.ph_hi = N_PHASES; a.li = 0;
    hipLaunchKernelGGL(fwd_megakernel, dim3(grid), dim3(NWAVES * 64), LDS_BYTES, stream, a);
#endif
}
```
